# Optimizing an MI355X kernel written in HIP

```python
import jax, jax.numpy as jnp
from jax import lax
import numpy as np

D_MODEL = 2048
BATCH = 4
SEQ = 4096
DEPTH = 1

GRID_W = 64
CTX_LEN = 256
D_FF = 5632
MACARON_WEIGHT = 0.5
CONV_W = 1024
GLA_HEADS = 4
GLA_DK = 1024
GLA_DV = 2048
HEAD_K = GLA_DK // GLA_HEADS
HEAD_V = GLA_DV // GLA_HEADS
GATE_RANK = 16
GATE_TAU = 16.0
CHUNK = 64
N_MOD = 9
EPS = 1e-6
PROJ_SIZES = (CONV_W, CONV_W, CONV_W, GLA_DK, GLA_DK, GLA_DV, GLA_DV, GATE_RANK, GATE_RANK, D_MODEL, D_MODEL)
D_IN = 3 * CONV_W + 2 * GLA_DK + 2 * GLA_DV + 2 * GATE_RANK + 2 * D_MODEL

kernel_name = "hybrid_conv_gla_macaron_prefix_block"


def rmsnorm(x, g):
    xf = x.astype(jnp.float32)
    y = xf * lax.rsqrt(jnp.mean(xf * xf, axis=-1, keepdims=True) + EPS)
    return (y * g.astype(jnp.float32)).astype(x.dtype)


def modulate(u, shift, scale):
    return u * (1 + scale) + shift


def ffn_sublayer(h, shift, scale, gate, g_pre, g_post, w_in, w_out):
    u = modulate(rmsnorm(h, g_pre), shift, scale)
    a, b = jnp.split(u @ w_in, 2, axis=-1)
    y = (jax.nn.silu(b) * a) @ w_out
    return h + MACARON_WEIGHT * gate * rmsnorm(y, g_post)


def split_projection(u, w_in):
    points = np.cumsum(np.array(PROJ_SIZES))[:-1].tolist()
    return jnp.split(u @ w_in, points, axis=-1)


def conv3(z, w, b):
    zp = jnp.pad(z, [(0, 0)] * (z.ndim - 2) + [(1, 1), (0, 0)])
    return zp[..., :-2, :] * w[0] + zp[..., 1:-1, :] * w[1] + zp[..., 2:, :] * w[2] + b


def conv_branch(bg, cg, hv, w, b, w_out, on_grid):
    z = cg * hv
    if on_grid:
        bsz, length, ch = z.shape
        rows = length // GRID_W
        y = conv3(z.reshape(bsz, rows, GRID_W, ch), w, b).reshape(bsz, length, ch)
    else:
        y = conv3(z, w, b)
    return (bg * y) @ w_out


def to_heads(t):
    bsz, length, width = t.shape
    return t.reshape(bsz, length, GLA_HEADS, width // GLA_HEADS).transpose(0, 2, 1, 3).astype(jnp.float32)


def flip(t):
    return jnp.flip(t, axis=2)


def log_decay(lo, w_up, bias):
    return jax.nn.log_sigmoid((lo @ w_up + bias).astype(jnp.float32)) / GATE_TAU


def gla_prepare(q, k, v, lo_f, lo_b, gate_up, gate_bias):
    qh = to_heads(q) * HEAD_K ** -0.5
    kh = to_heads(k)
    vh = to_heads(v)
    la_f = to_heads(log_decay(lo_f, gate_up[0], gate_bias[0]))
    la_b = to_heads(log_decay(lo_b, gate_up[1], gate_bias[1]))
    return qh, kh, vh, la_f, la_b


def gla_chunked(q, k, v, log_a, s0):
    bsz, nh, length, dk = q.shape
    dv = v.shape[-1]
    n = length // CHUNK
    rs = lambda t: t.reshape(bsz, nh, n, CHUNK, t.shape[-1])
    q, k, v, log_a = rs(q), rs(k), rs(v), rs(log_a)
    b = jnp.cumsum(log_a, axis=-2)
    b_mid = b[..., CHUNK // 2 - 1:CHUNK // 2, :]
    b_last = b[..., -1:, :]
    scores = jnp.einsum('bhnck,bhnsk->bhncs', q * jnp.exp(b - b_mid), k * jnp.exp(b_mid - b))
    mask = jnp.tril(jnp.ones((CHUNK, CHUNK), dtype=bool))
    o_intra = jnp.einsum('bhncs,bhnsv->bhncv', jnp.where(mask, scores, 0.0), v)
    q_dec = q * jnp.exp(b)
    k_dec = k * jnp.exp(b_last - b)
    a_last = jnp.exp(b_last[..., 0, :])

    def step(s, xs):
        qd, kd, vc, al = xs
        o = jnp.einsum('bhck,bhkv->bhcv', qd, s)
        s = al[..., None] * s + jnp.einsum('bhck,bhcv->bhkv', kd, vc)
        return s, o

    mv = lambda t: jnp.moveaxis(t, 2, 0)
    s_final, o_inter = lax.scan(step, s0, (mv(q_dec), mv(k_dec), mv(v), mv(a_last)))
    o = o_intra + jnp.moveaxis(o_inter, 0, 2)
    return o.reshape(bsz, nh, length, dv), s_final


def gla_final_state(k, v, log_a):
    b = jnp.cumsum(log_a, axis=-2)
    k_dec = k * jnp.exp(b[..., -1:, :] - b)
    return jnp.einsum('bhlk,bhlv->bhkv', k_dec, v)


def gla_readout(o, r, g, w_out):
    on = o * lax.rsqrt(jnp.mean(o * o, axis=-1, keepdims=True) + EPS)
    bsz, nh, length, dv = o.shape
    on = on.transpose(0, 2, 1, 3).reshape(bsz, length, nh * dv).astype(r.dtype)
    return (on * g * jax.nn.silu(r)) @ w_out


def merge_branches(y_a, y_b, g_a, g_b, w_o):
    return (jax.nn.sigmoid(g_a) * y_a + jax.nn.sigmoid(g_b) * y_b) @ w_o


def setup_inputs(seed: int = 0) -> dict:
    key = jax.random.key(seed)
    ks = jax.random.split(key, 24)
    nrm = lambda k, shape: jax.random.normal(k, shape, jnp.float32)
    L = DEPTH
    return {
        "x": nrm(ks[0], (BATCH, SEQ, D_MODEL)),
        "c": nrm(ks[1], (BATCH, D_MODEL)),
        "ctx": nrm(ks[2], (BATCH, CTX_LEN, D_MODEL)),
        "c_ctx": nrm(ks[3], (D_MODEL,)),
        "w_mod": nrm(ks[4], (L, D_MODEL, N_MOD * D_MODEL)) * (0.5 * D_MODEL ** -0.5),
        "b_mod": nrm(ks[5], (L, N_MOD * D_MODEL)) * 0.02,
        "norm_g": 1.0 + 0.05 * nrm(ks[6], (L, 6, D_MODEL)),
        "ffn1_w_in": nrm(ks[7], (L, D_MODEL, 2 * D_FF)) * D_MODEL ** -0.5,
        "ffn1_w_out": nrm(ks[8], (L, D_FF, D_MODEL)) * D_FF ** -0.5,
        "w_in": nrm(ks[9], (L, D_MODEL, D_IN)) * D_MODEL ** -0.5,
        "conv_w": nrm(ks[10], (L, 3, CONV_W)) * 3.0 ** -0.5,
        "conv_b": nrm(ks[11], (L, CONV_W)) * 0.02,
        "conv_out": nrm(ks[12], (L, CONV_W, D_MODEL)) * CONV_W ** -0.5,
        "gate_up": nrm(ks[13], (L, 2, GATE_RANK, GLA_DK)) * GATE_RANK ** -0.5,
        "gate_bias": nrm(ks[14], (L, 2, GLA_DK)) * 0.1,
        "gla_norm_g": 1.0 + 0.05 * nrm(ks[15], (L, GLA_DV)),
        "gla_out": nrm(ks[16], (L, GLA_DV, D_MODEL)) * GLA_DV ** -0.5,
        "w_o": nrm(ks[17], (L, D_MODEL, D_MODEL)) * D_MODEL ** -0.5,
        "ffn2_w_in": nrm(ks[18], (L, D_MODEL, 2 * D_FF)) * D_MODEL ** -0.5,
        "ffn2_w_out": nrm(ks[19], (L, D_FF, D_MODEL)) * D_FF ** -0.5,
    }


def reference(x, c, ctx, c_ctx, w_mod, b_mod, norm_g, ffn1_w_in, ffn1_w_out, w_in, conv_w, conv_b,
              conv_out, gate_up, gate_bias, gla_norm_g, gla_out, w_o, ffn2_w_in, ffn2_w_out):
    for l in range(DEPTH):
        last = l == DEPTH - 1
        g = norm_g[l]
        m_x = [m[:, None, :] for m in jnp.split(jax.nn.silu(c) @ w_mod[l] + b_mod[l], N_MOD, axis=-1)]
        m_c = jnp.split(jax.nn.silu(c_ctx) @ w_mod[l] + b_mod[l], N_MOD, axis=-1)

        x = ffn_sublayer(x, m_x[0], m_x[1], m_x[2], g[0], g[1], ffn1_w_in[l], ffn1_w_out[l])
        ctx = ffn_sublayer(ctx, m_c[0], m_c[1], m_c[2], g[0], g[1], ffn1_w_in[l], ffn1_w_out[l])

        bg, cg, hv, q, k, v, r, lo_f, lo_b, g_a, g_b = split_projection(
            modulate(rmsnorm(x, g[2]), m_x[3], m_x[4]), w_in[l])
        cbg, ccg, chv, cq, ck, cv, cr, clo_f, clo_b, cg_a, cg_b = split_projection(
            modulate(rmsnorm(ctx, g[2]), m_c[3], m_c[4]), w_in[l])
        qh, kh, vh, la_f, la_b = gla_prepare(q, k, v, lo_f, lo_b, gate_up[l], gate_bias[l])
        cqh, ckh, cvh, cla_f, cla_b = gla_prepare(cq, ck, cv, clo_f, clo_b, gate_up[l], gate_bias[l])

        if last:
            s_f = gla_final_state(ckh, cvh, cla_f)
            s_b = gla_final_state(flip(ckh), flip(cvh), flip(cla_b))
        else:
            zero = jnp.zeros(ckh.shape[:2] + (HEAD_K, HEAD_V), jnp.float32)
            co_f, s_f = gla_chunked(cqh, ckh, cvh, cla_f, zero)
            co_b, s_b = gla_chunked(flip(cqh), flip(ckh), flip(cvh), flip(cla_b), zero)
            cy = merge_branches(
                conv_branch(cbg, ccg, chv, conv_w[l], conv_b[l], conv_out[l], False),
                gla_readout(co_f + flip(co_b), cr, gla_norm_g[l], gla_out[l]),
                cg_a, cg_b, w_o[l])
            ctx = ctx + m_c[5] * rmsnorm(cy, g[3])
            ctx = ffn_sublayer(ctx, m_c[6], m_c[7], m_c[8], g[4], g[5], ffn2_w_in[l], ffn2_w_out[l])

        o_f, _ = gla_chunked(qh, kh, vh, la_f, s_f)
        o_b, _ = gla_chunked(flip(qh), flip(kh), flip(vh), flip(la_b), s_b)
        y = merge_branches(
            conv_branch(bg, cg, hv, conv_w[l], conv_b[l], conv_out[l], True),
            gla_readout(o_f + flip(o_b), r, gla_norm_g[l], gla_out[l]),
            g_a, g_b, w_o[l])
        x = x + m_x[5] * rmsnorm(y, g[3])

        x = ffn_sublayer(x, m_x[6], m_x[7], m_x[8], g[4], g[5], ffn2_w_in[l], ffn2_w_out[l])
    return x
```

```cpp
#include <hip/hip_runtime.h>
#include <hip/hip_cooperative_groups.h>
#include <cstdio>
namespace cg = cooperative_groups;
#ifndef MULTI_LAUNCH
#define MULTI_LAUNCH 0
#endif
#define LAS __attribute__((address_space(3)))
typedef unsigned short bf16_t;
typedef short bf16x8 __attribute__((ext_vector_type(8)));
typedef float f32x4 __attribute__((ext_vector_type(4)));
typedef unsigned u32x4 __attribute__((ext_vector_type(4)));
typedef unsigned u32x2 __attribute__((ext_vector_type(2)));

constexpr int DM = 2048, NB = 4, SEQ = 4096, CTXL = 256, DFF = 5632, CONVW = 1024, NH = 4, HK = 256, HV = 512;
constexpr int ML = NB * SEQ, MC = NB * CTXL, MT = ML + MC;
constexpr int DIN = 13344, NMODC = 9 * DM;
constexpr int KSPLIT = 8;
constexpr float EPS = 1e-6f;
constexpr size_t MiB = 1048576;
constexpr size_t OFF_W1IN = 0, OFF_W1OUT = 44 * MiB, OFF_WPA = 66 * MiB, OFF_WPB = 83 * MiB, OFF_WCO = 119 * MiB, OFF_WGO = 123 * MiB, OFF_WO = 131 * MiB;
constexpr size_t OFF_U = 139 * MiB, OFF_R = 207 * MiB;
constexpr size_t OFF_ACT = OFF_R, OFF_Y = 394 * MiB, OFF_YC = 530 * MiB;
constexpr size_t OFF_Q = 207 * MiB, OFF_K = 241 * MiB, OFF_VT = 275 * MiB, OFF_QD = 343 * MiB, OFF_KDT = 407 * MiB, OFF_PS = 475 * MiB, OFF_OF = 495 * MiB, OFF_OB = 559 * MiB;
constexpr size_t OFF_PBC = 207 * MiB, OFF_PBR = 303 * MiB, OFF_PBG = 367 * MiB, OFF_T = 495 * MiB, OFF_Z = OFF_PBR, OFF_Y2 = 495 * MiB;
constexpr size_t OFF_ACONV = 66 * MiB, OFF_AGLA = OFF_U;
constexpr size_t OFF_MODP = 640 * MiB, OFF_CX1 = 643 * MiB, OFF_LO = 651 * MiB, OFF_AL = 654 * MiB, OFF_BAR = 657 * MiB, WS_NEED = 658 * MiB;
constexpr int LDS_BYTES = 160 * 1024;

struct Params {
  const float *x, *c, *ctx, *c_ctx, *w_mod, *b_mod, *norm_g, *ffn1_w_in, *ffn1_w_out, *w_in, *conv_w, *conv_b, *conv_out, *gate_up, *gate_bias, *gla_norm_g, *gla_out, *w_o, *ffn2_w_in, *ffn2_w_out;
  float* out; unsigned char* ws; int ph_lo, ph_hi;
};

typedef float f32x2 __attribute__((ext_vector_type(2)));
typedef __bf16 bf16x2_t __attribute__((ext_vector_type(2)));
__device__ __forceinline__ unsigned cvt_pk_bf16(float lo, float hi) { const f32x2 v = {lo, hi}; return __builtin_bit_cast(unsigned, __builtin_convertvector(v, bf16x2_t)); }
__device__ __forceinline__ float bf_lo(unsigned w) { return __uint_as_float(w << 16); }
__device__ __forceinline__ float bf_hi(unsigned w) { return __uint_as_float(w & 0xffff0000u); }
__device__ __forceinline__ float fsigmoid(float v) { return __builtin_amdgcn_rcpf(1.0f + __expf(-v)); }
__device__ __forceinline__ float fsilu(float v) { return v * fsigmoid(v); }
__device__ __forceinline__ float wave_sum(float v) {
#pragma unroll
  for (int o = 32; o >= 1; o >>= 1) v += __shfl_xor(v, o);
  return v;
}

namespace pg8 {
constexpr int BM = 256, BK = 64, HALF = 128, HTB = HALF * BK * 2, STAGE_BYTES = 8 * HTB, NXCD = 8, WGM = 8;
__host__ __device__ __forceinline__ int lds_byte(int r, int c) { const int st = (r >> 4) * 2 + (c >> 5), rr = r & 15, cc = c & 31, ob = rr * 64 + cc * 2; return st * 1024 + (ob ^ (((ob >> 9) & 1) << 5)); }
__host__ __device__ __forceinline__ void stage_rc(int b, int& R, int& C) { const int st = b / 1024, sb = b % 1024, swz = sb ^ (((sb >> 9) & 1) << 5); R = (st >> 1) * 16 + swz / 64; C = (st & 1) * 32 + (swz % 64) / 2; }
__host__ __device__ __forceinline__ int perm32(int rho) { const int n = rho >> 4, i = rho & 15; return 8 * (i >> 2) + 4 * n + (i & 3); }
struct Unit { int pm, pn, ks; };
struct Gemm { const bf16_t* A; const bf16_t* Bt; int M, N, K, ld; };
struct StaticOrder {
  int nM, nN, nwg, G, c, nsplit;
  __device__ void init(int M, int N, int G_, int c_, int nsplit_ = 1) { nM = M / BM; nN = N / BM; nwg = nM * nN; G = G_; c = c_; nsplit = nsplit_; }
  __device__ bool next(int i, Unit& u) const {
    const long L = (long)i * G + c; if (L >= (long)nwg * nsplit) return false;
    u.ks = (int)(L / nwg);
    int wgid = (int)(L % nwg); { const int q = nwg / NXCD, r = nwg % NXCD, xcd = wgid % NXCD, off = wgid / NXCD; wgid = (xcd < r ? xcd * (q + 1) : r * (q + 1) + (xcd - r) * q) + off; }
    const int nig = WGM * nN, gid = wgid / nig, fm = gid * WGM, gsz = (nM - fm) < WGM ? (nM - fm) : WGM;
    u.pm = fm + ((wgid % nig) % gsz); u.pn = (wgid % nig) / gsz; return true;
  }
};

template <class Epi>
__device__ __forceinline__ void gemm_phase(LAS unsigned char* lds, const Gemm g, const StaticOrder& S, const Epi& E) {
  const int tid = threadIdx.x, wid = __builtin_amdgcn_readfirstlane(tid >> 6), lane = tid & 63, wr = wid >> 2, wc = wid & 3, fr = lane & 15, fq = lane >> 4;
  const int K = g.K, nt = K / BK, ld = g.ld;
  unsigned voffA[2], voffB[2];
#pragma unroll
  for (int i = 0; i < 2; ++i) { int R, C; stage_rc(tid * 16 + i * 8192, R, C); const int Rb = Epi::PERM ? ((R & ~31) + perm32(R & 31)) : R;
    voffA[i] = (unsigned)(R * ld + C) * 2u; voffB[i] = (unsigned)(Rb * ld + C) * 2u; }
  const size_t kstep = (size_t)(BK * 2);
  const size_t hstep = (size_t)HALF * ld * 2;
  const size_t sstep = (size_t)K * 2;
  const size_t tstep = 2 * hstep;
  const unsigned ldsw = (unsigned)wid * 1024u;
  const int aoff = lds_byte(wr * 64 + fr, fq * 8), boff = lds_byte(wc * 32 + fr, fq * 8);
#define PG8_SA(b, h) (((b) * 2 + (h)) * HTB)
#define PG8_SB(b, h) ((4 + (b) * 2 + (h)) * HTB)
#define PG8_STAGE(bufoff, gbase, voff) do { _Pragma("unroll") for (int _i = 0; _i < 2; ++_i) \
    __builtin_amdgcn_global_load_lds((const unsigned*)((const char*)(gbase) + (voff)[_i]), (LAS unsigned*)(lds + (bufoff) + ldsw + _i * 8192), 16, 0, 0); } while (0)
#define PG8_LDA(dst, b, h) do { _Pragma("unroll") for (int m = 0; m < 4; ++m) _Pragma("unroll") for (int k = 0; k < 2; ++k) dst[m][k] = *(const LAS bf16x8*)(lds + PG8_SA(b, h) + aoff + m * 2048 + k * 1024); } while (0)
#define PG8_LDB(dst, b, h) do { _Pragma("unroll") for (int n = 0; n < 2; ++n) _Pragma("unroll") for (int k = 0; k < 2; ++k) dst[n][k] = *(const LAS bf16x8*)(lds + PG8_SB(b, h) + boff + n * 2048 + k * 1024); } while (0)
#define PG8_MMA(ai, bj, At, Bt) do { __builtin_amdgcn_s_setprio(1); _Pragma("unroll") for (int m = 0; m < 4; ++m) _Pragma("unroll") for (int n = 0; n < 2; ++n) _Pragma("unroll") for (int k = 0; k < 2; ++k) \
    acc[ai][bj][m][n] = __builtin_amdgcn_mfma_f32_16x16x32_bf16(Bt[n][k], At[m][k], acc[ai][bj][m][n], 0, 0, 0); __builtin_amdgcn_s_setprio(0); } while (0)
#define PG8_WAIT_V(n) asm volatile("s_waitcnt vmcnt(" #n ")" ::: "memory")
#define PG8_WAIT_L(n) asm volatile("s_waitcnt lgkmcnt(" #n ")" ::: "memory")
#define PG8_BAR __builtin_amdgcn_s_barrier()
#define PG8_SCHED __builtin_amdgcn_sched_barrier(0)
  Unit cur, nxt; int ui = 0;
  if (!S.next(0, cur)) return;
  f32x4 acc[2][2][4][2];
#pragma unroll
  for (int a = 0; a < 2; ++a)
#pragma unroll
    for (int b = 0; b < 2; ++b)
#pragma unroll
      for (int m = 0; m < 4; ++m)
#pragma unroll
        for (int n = 0; n < 2; ++n) acc[a][b][m][n] = (f32x4){0.f, 0.f, 0.f, 0.f};
  bf16x8 At[4][2], B0[2][2], B1[2][2];
  const char* cA = (const char*)g.A + (size_t)cur.pm * tstep + (size_t)cur.ks * sstep; const char* cB = (const char*)g.Bt + (size_t)cur.pn * tstep + (size_t)cur.ks * sstep;
  PG8_STAGE(PG8_SB(0, 0), cB, voffB); PG8_STAGE(PG8_SA(0, 0), cA, voffA); PG8_STAGE(PG8_SB(0, 1), cB + hstep, voffB); PG8_STAGE(PG8_SA(0, 1), cA + hstep, voffA);
  if (wr == 1) PG8_BAR;
  PG8_WAIT_V(4); PG8_BAR;
  PG8_STAGE(PG8_SB(1, 0), cB + kstep, voffB); PG8_STAGE(PG8_SA(1, 0), cA + kstep, voffA); PG8_STAGE(PG8_SB(1, 1), cB + hstep + kstep, voffB);
  PG8_WAIT_V(6); PG8_BAR;
  for (;;) {
    const bool has_next = S.next(ui + 1, nxt);
    const char* nA = has_next ? (const char*)g.A + (size_t)nxt.pm * tstep + (size_t)nxt.ks * sstep : cA; const char* nB = has_next ? (const char*)g.Bt + (size_t)nxt.pn * tstep + (size_t)nxt.ks * sstep : cB;
    for (int t = 0; t < nt; t += 2) {
      const bool last = (t == nt - 2);
      const char* a1 = cA + (size_t)(t + 1) * kstep;
      const char* a2 = last ? nA : cA + (size_t)(t + 2) * kstep; const char* b2 = last ? nB : cB + (size_t)(t + 2) * kstep;
      const char* a3 = a2 + kstep; const char* b3 = b2 + kstep;
      PG8_LDB(B0, 0, 0); PG8_SCHED; PG8_LDA(At, 0, 0); PG8_STAGE(PG8_SA(1, 1), a1 + hstep, voffA);
      PG8_WAIT_L(8); PG8_BAR; PG8_WAIT_L(0); PG8_MMA(0, 0, At, B0); PG8_BAR; PG8_SCHED;
      PG8_LDB(B1, 0, 1); PG8_STAGE(PG8_SB(0, 0), b2, voffB);
      PG8_BAR; PG8_WAIT_L(0); PG8_MMA(0, 1, At, B1); PG8_BAR;
      PG8_LDA(At, 0, 1); PG8_STAGE(PG8_SA(0, 0), a2, voffA);
      PG8_BAR; PG8_WAIT_L(0); PG8_MMA(1, 0, At, B0); PG8_BAR; PG8_SCHED;
      PG8_STAGE(PG8_SB(0, 1), b2 + hstep, voffB);
      PG8_WAIT_V(6); PG8_BAR; PG8_MMA(1, 1, At, B1); PG8_BAR;
      PG8_LDB(B0, 1, 0); PG8_SCHED; PG8_LDA(At, 1, 0); PG8_STAGE(PG8_SA(0, 1), a2 + hstep, voffA);
      PG8_WAIT_L(8); PG8_BAR; PG8_WAIT_L(0); PG8_MMA(0, 0, At, B0); PG8_BAR; PG8_SCHED;
      PG8_LDB(B1, 1, 1); PG8_STAGE(PG8_SB(1, 0), b3, voffB);
      PG8_BAR; PG8_WAIT_L(0); PG8_MMA(0, 1, At, B1); PG8_BAR;
      PG8_LDA(At, 1, 1); PG8_STAGE(PG8_SA(1, 0), a3, voffA);
      PG8_BAR; PG8_WAIT_L(0); PG8_MMA(1, 0, At, B0); PG8_BAR; PG8_SCHED;
      PG8_STAGE(PG8_SB(1, 1), b3 + hstep, voffB);
      PG8_WAIT_V(6); PG8_BAR; PG8_MMA(1, 1, At, B1); PG8_BAR;
    }
    E(acc, cur, wr, wc, fr, fq);
    if (!has_next) break;
#pragma unroll
    for (int a = 0; a < 2; ++a)
#pragma unroll
      for (int b = 0; b < 2; ++b)
#pragma unroll
        for (int m = 0; m < 4; ++m)
#pragma unroll
          for (int n = 0; n < 2; ++n) acc[a][b][m][n] = (f32x4){0.f, 0.f, 0.f, 0.f};
    cur = nxt; cA = nA; cB = nB; ++ui;
  }
  PG8_WAIT_V(0);
  if (wr == 0) PG8_BAR;
  PG8_BAR;
#undef PG8_SA
#undef PG8_SB
#undef PG8_STAGE
#undef PG8_LDA
#undef PG8_LDB
#undef PG8_MMA
#undef PG8_WAIT_V
#undef PG8_WAIT_L
#undef PG8_BAR
#undef PG8_SCHED
}
}
using pg8::Unit;
typedef f32x4 AccT[2][2][4][2];

struct EpiSwiglu {
  static constexpr bool PERM = true; bf16_t* O;
  __device__ __forceinline__ void operator()(const AccT& acc, const Unit& u, int wr, int wc, int fr, int fq) const {
    const int row0 = u.pm * 256 + wr * 64 + fr, col0 = u.pn * 128 + wc * 32 + 8 * fq;
#pragma unroll
    for (int ai = 0; ai < 2; ++ai)
#pragma unroll
      for (int m = 0; m < 4; ++m) {
        bf16_t* rowp = O + (size_t)(row0 + ai * 128 + m * 16) * DFF + col0;
        float h[8];
#pragma unroll
        for (int n = 0; n < 2; ++n)
#pragma unroll
          for (int j = 0; j < 4; ++j) { const float a = acc[ai][0][m][n][j], b = acc[ai][1][m][n][j]; h[n * 4 + j] = a * fsilu(b); }
        u32x4 w; w.x = cvt_pk_bf16(h[0], h[1]); w.y = cvt_pk_bf16(h[2], h[3]); w.z = cvt_pk_bf16(h[4], h[5]); w.w = cvt_pk_bf16(h[6], h[7]);
        __builtin_nontemporal_store(w, (u32x4*)rowp);
      }
  }
};
struct EpiF32 {
  static constexpr bool PERM = false; float* C; int ldc;
  __device__ __forceinline__ void operator()(const AccT& acc, const Unit& u, int wr, int wc, int fr, int fq) const {
    const int row0 = u.pm * 256 + wr * 64 + fr, col0 = u.pn * 256 + wc * 32 + 4 * fq;
#pragma unroll
    for (int ai = 0; ai < 2; ++ai)
#pragma unroll
      for (int m = 0; m < 4; ++m) { float* rowp = C + (size_t)(row0 + ai * 128 + m * 16) * ldc + col0;
#pragma unroll
        for (int bj = 0; bj < 2; ++bj)
#pragma unroll
          for (int n = 0; n < 2; ++n) *(f32x4*)(rowp + bj * 128 + n * 16) = acc[ai][bj][m][n]; }
  }
};
struct EpiBf16 {
  static constexpr bool PERM = true; bf16_t* O; int nT;
  __device__ __forceinline__ void operator()(const AccT& acc, const Unit& u, int wr, int wc, int fr, int fq) const {
    bf16_t* base = O + ((size_t)(u.pm * nT + u.pn) << 16) + (wr * 64 + fr) * 256 + wc * 32 + 8 * fq;
#pragma unroll
    for (int ai = 0; ai < 2; ++ai)
#pragma unroll
      for (int m = 0; m < 4; ++m) { bf16_t* rowp = base + (ai * 128 + m * 16) * 256;
#pragma unroll
        for (int bj = 0; bj < 2; ++bj) { const f32x4 v0 = acc[ai][bj][m][0], v1 = acc[ai][bj][m][1];
          u32x4 w; w.x = cvt_pk_bf16(v0[0], v0[1]); w.y = cvt_pk_bf16(v0[2], v0[3]); w.z = cvt_pk_bf16(v1[0], v1[1]); w.w = cvt_pk_bf16(v1[2], v1[3]);
          *(u32x4*)(rowp + bj * 128) = w; } }
  }
};
struct EpiF32Split {
  static constexpr bool PERM = false; float* C; int ldc; size_t slab;
  __device__ __forceinline__ void operator()(const AccT& acc, const Unit& u, int wr, int wc, int fr, int fq) const {
    const int row0 = u.pm * 256 + wr * 64 + fr, col0 = u.pn * 256 + wc * 32 + 4 * fq; float* base = C + (size_t)u.ks * slab;
#pragma unroll
    for (int ai = 0; ai < 2; ++ai)
#pragma unroll
      for (int m = 0; m < 4; ++m) { float* rowp = base + (size_t)(row0 + ai * 128 + m * 16) * ldc + col0;
#pragma unroll
        for (int bj = 0; bj < 2; ++bj)
#pragma unroll
          for (int n = 0; n < 2; ++n) *(f32x4*)(rowp + bj * 128 + n * 16) = acc[ai][bj][m][n]; }
  }
};
struct EpiPA {
  static constexpr bool PERM = true; bf16_t *Q, *K, *VT; float* LO;
  __device__ __forceinline__ void operator()(const AccT& acc, const Unit& u, int wr, int wc, int fr, int fq) const {
    const int row0 = u.pm * 256 + wr * 64 + fr;
    if (u.pn < 8) {
      bf16_t* base = (u.pn < 4 ? Q : K) + ((size_t)(u.pm * 4 + (u.pn & 3)) << 16) + (wr * 64 + fr) * 256 + wc * 32 + 8 * fq;
#pragma unroll
      for (int ai = 0; ai < 2; ++ai)
#pragma unroll
        for (int m = 0; m < 4; ++m) { bf16_t* rowp = base + (ai * 128 + m * 16) * 256;
#pragma unroll
          for (int bj = 0; bj < 2; ++bj) { const f32x4 v0 = acc[ai][bj][m][0], v1 = acc[ai][bj][m][1];
            u32x4 w; w.x = cvt_pk_bf16(v0[0], v0[1]); w.y = cvt_pk_bf16(v0[2], v0[3]); w.z = cvt_pk_bf16(v1[0], v1[1]); w.w = cvt_pk_bf16(v1[2], v1[3]);
            *(u32x4*)(rowp + bj * 128) = w; } }
    } else if (u.pn < 16) {
      const int hv0 = (u.pn - 8) * 256 + wc * 32 + 8 * fq;
#pragma unroll
      for (int ai = 0; ai < 2; ++ai)
#pragma unroll
        for (int m = 0; m < 4; ++m) { const int row = row0 + ai * 128 + m * 16; const int gid = row >> 6, s = row & 63;
          bf16_t* bp = VT + ((size_t)gid * 2048 + hv0) * 64 + s;
#pragma unroll
          for (int bj = 0; bj < 2; ++bj)
#pragma unroll
            for (int n = 0; n < 2; ++n) { const f32x4 v = acc[ai][bj][m][n]; const unsigned w0 = cvt_pk_bf16(v[0], v[1]), w1 = cvt_pk_bf16(v[2], v[3]);
              bf16_t* q = bp + (size_t)(bj * 128 + 4 * n) * 64;
              q[0] = (bf16_t)(w0 & 0xffffu); q[64] = (bf16_t)(w0 >> 16); q[128] = (bf16_t)(w1 & 0xffffu); q[192] = (bf16_t)(w1 >> 16); } }
    } else {
      if (wc == 0) {
#pragma unroll
        for (int ai = 0; ai < 2; ++ai)
#pragma unroll
          for (int m = 0; m < 4; ++m) { float* rowp = LO + (size_t)(row0 + ai * 128 + m * 16) * 32 + 8 * fq;
            *(f32x4*)rowp = acc[ai][0][m][0]; *(f32x4*)(rowp + 4) = acc[ai][0][m][1]; }
      }
    }
  }
};
struct EpiPB {
  static constexpr bool PERM = true; bf16_t *PBc, *PBr, *PBg;
  __device__ __forceinline__ void operator()(const AccT& acc, const Unit& u, int wr, int wc, int fr, int fq) const {
    bf16_t* buf; int nT, pl;
    if (u.pn < 12) { buf = PBc; nT = 12; pl = u.pn; } else if (u.pn < 20) { buf = PBr; nT = 8; pl = u.pn - 12; } else { buf = PBg; nT = 16; pl = u.pn - 20; }
    bf16_t* base = buf + ((size_t)(u.pm * nT + pl) << 16) + (wr * 64 + fr) * 256 + wc * 32 + 8 * fq;
#pragma unroll
    for (int ai = 0; ai < 2; ++ai)
#pragma unroll
      for (int m = 0; m < 4; ++m) { bf16_t* rowp = base + (ai * 128 + m * 16) * 256;
#pragma unroll
        for (int bj = 0; bj < 2; ++bj) { const f32x4 v0 = acc[ai][bj][m][0], v1 = acc[ai][bj][m][1];
          u32x4 w; w.x = cvt_pk_bf16(v0[0], v0[1]); w.y = cvt_pk_bf16(v0[2], v0[3]); w.z = cvt_pk_bf16(v1[0], v1[1]); w.w = cvt_pk_bf16(v1[2], v1[3]);
          __builtin_nontemporal_store(w, (u32x4*)(rowp + bj * 128)); } }
  }
};
struct EpiGateT {
  static constexpr bool PERM = true; const bf16_t* PBg; bf16_t* T;
  __device__ __forceinline__ void operator()(const AccT& acc, const Unit& u, int wr, int wc, int fr, int fq) const {
    const int toff = (wr * 64 + fr) * 256 + wc * 32 + 8 * fq;
    const bf16_t* gb = PBg + ((size_t)(u.pm * 16 + u.pn) << 16) + toff; bf16_t* tb = T + ((size_t)(u.pm * 8 + u.pn) << 16) + toff;
#pragma unroll
    for (int ai = 0; ai < 2; ++ai) {
      u32x4 g[4][2];
#pragma unroll
      for (int m = 0; m < 4; ++m)
#pragma unroll
        for (int bj = 0; bj < 2; ++bj) g[m][bj] = *(const u32x4*)(gb + (ai * 128 + m * 16) * 256 + bj * 128);
#pragma unroll
      for (int m = 0; m < 4; ++m)
#pragma unroll
        for (int bj = 0; bj < 2; ++bj) { const u32x4 gg = g[m][bj]; const f32x4 a0 = acc[ai][bj][m][0], a1 = acc[ai][bj][m][1];
          float z[8];
          z[0] = a0[0] * fsigmoid(bf_lo(gg.x)); z[1] = a0[1] * fsigmoid(bf_hi(gg.x)); z[2] = a0[2] * fsigmoid(bf_lo(gg.y)); z[3] = a0[3] * fsigmoid(bf_hi(gg.y));
          z[4] = a1[0] * fsigmoid(bf_lo(gg.z)); z[5] = a1[1] * fsigmoid(bf_hi(gg.z)); z[6] = a1[2] * fsigmoid(bf_lo(gg.w)); z[7] = a1[3] * fsigmoid(bf_hi(gg.w));
          u32x4 w; w.x = cvt_pk_bf16(z[0], z[1]); w.y = cvt_pk_bf16(z[2], z[3]); w.z = cvt_pk_bf16(z[4], z[5]); w.w = cvt_pk_bf16(z[6], z[7]);
          *(u32x4*)(tb + (ai * 128 + m * 16) * 256 + bj * 128) = w; }
    }
  }
};
struct EpiGateZ {
  static constexpr bool PERM = true; const bf16_t* PBg; const bf16_t* T; bf16_t* Z;
  __device__ __forceinline__ void operator()(const AccT& acc, const Unit& u, int wr, int wc, int fr, int fq) const {
    const int row0 = u.pm * 256 + wr * 64 + fr, col0 = u.pn * 256 + wc * 32 + 8 * fq;
    const int toff = (wr * 64 + fr) * 256 + wc * 32 + 8 * fq;
    const bf16_t* gb = PBg + ((size_t)(u.pm * 16 + 8 + u.pn) << 16) + toff; const bf16_t* tb = T + ((size_t)(u.pm * 8 + u.pn) << 16) + toff;
#pragma unroll
    for (int ai = 0; ai < 2; ++ai) {
      u32x4 g[4][2], tt[4][2];
#pragma unroll
      for (int m = 0; m < 4; ++m)
#pragma unroll
        for (int bj = 0; bj < 2; ++bj) { g[m][bj] = *(const u32x4*)(gb + (ai * 128 + m * 16) * 256 + bj * 128); tt[m][bj] = *(const u32x4*)(tb + (ai * 128 + m * 16) * 256 + bj * 128); }
#pragma unroll
      for (int m = 0; m < 4; ++m) { const size_t row = (size_t)(row0 + ai * 128 + m * 16);
#pragma unroll
        for (int bj = 0; bj < 2; ++bj) { const int col = col0 + bj * 128; const u32x4 gg = g[m][bj], tw = tt[m][bj]; const f32x4 a0 = acc[ai][bj][m][0], a1 = acc[ai][bj][m][1];
          float z[8];
          z[0] = bf_lo(tw.x) + a0[0] * fsigmoid(bf_lo(gg.x)); z[1] = bf_hi(tw.x) + a0[1] * fsigmoid(bf_hi(gg.x)); z[2] = bf_lo(tw.y) + a0[2] * fsigmoid(bf_lo(gg.y)); z[3] = bf_hi(tw.y) + a0[3] * fsigmoid(bf_hi(gg.y));
          z[4] = bf_lo(tw.z) + a1[0] * fsigmoid(bf_lo(gg.z)); z[5] = bf_hi(tw.z) + a1[1] * fsigmoid(bf_hi(gg.z)); z[6] = bf_lo(tw.w) + a1[2] * fsigmoid(bf_lo(gg.w)); z[7] = bf_hi(tw.w) + a1[3] * fsigmoid(bf_hi(gg.w));
          u32x4 w; w.x = cvt_pk_bf16(z[0], z[1]); w.y = cvt_pk_bf16(z[2], z[3]); w.z = cvt_pk_bf16(z[4], z[5]); w.w = cvt_pk_bf16(z[6], z[7]);
          *(u32x4*)(Z + row * 2048 + col) = w; } }
    }
  }
};

template <class Epi>
__device__ __forceinline__ void run_gemm_v(int vb, LAS unsigned char* lds, const bf16_t* A, const bf16_t* Bt, int M, int N, int K, const Epi& E, int nsplit = 1) {
  pg8::Gemm g{A, Bt, M, N, K / nsplit, K}; pg8::StaticOrder S; S.init(M, N, (int)gridDim.x, vb, nsplit);
  pg8::gemm_phase<Epi>(lds, g, S, E);
}

__device__ __forceinline__ void phase_mod(const Params& p, LAS unsigned char* lds) {
  LAS float* sv = (LAS float*)lds;
  LAS float* red = (LAS float*)(lds + 8192);
  float* MODP = (float*)(p.ws + OFF_MODP);
  const int tid = threadIdx.x, wid = tid >> 6, lane = tid & 63;
  for (int item = blockIdx.x; item < 72 * KSPLIT; item += gridDim.x) {
    const int cc = item % 72, ks = item / 72;
    for (int i = tid; i < 5 * 256; i += 512) { const int r = i >> 8, k = ks * 256 + (i & 255); const float v = r < 4 ? p.c[r * DM + k] : p.c_ctx[k]; sv[i] = v / (1.f + __expf(-v)); }
    __syncthreads();
    f32x4 a0 = {0, 0, 0, 0}, a1 = a0, a2 = a0, a3 = a0, a4 = a0;
    const float* wp = p.w_mod + (size_t)(ks * 256 + wid * 32) * NMODC + cc * 256 + lane * 4;
#pragma unroll 8
    for (int k = 0; k < 32; ++k) {
      const f32x4 w = __builtin_nontemporal_load((const f32x4*)(wp + (size_t)k * NMODC));
      const int kk = wid * 32 + k;
      a0 += w * sv[kk]; a1 += w * sv[256 + kk]; a2 += w * sv[512 + kk]; a3 += w * sv[768 + kk]; a4 += w * sv[1024 + kk];
    }
    *(LAS f32x4*)(red + (wid * 5 + 0) * 256 + lane * 4) = a0; *(LAS f32x4*)(red + (wid * 5 + 1) * 256 + lane * 4) = a1; *(LAS f32x4*)(red + (wid * 5 + 2) * 256 + lane * 4) = a2;
    *(LAS f32x4*)(red + (wid * 5 + 3) * 256 + lane * 4) = a3; *(LAS f32x4*)(red + (wid * 5 + 4) * 256 + lane * 4) = a4;
    __syncthreads();
    for (int i = tid; i < 1280; i += 512) { const int r = i >> 8, col = i & 255; float s = 0.f;
#pragma unroll
      for (int w = 0; w < 8; ++w) s += red[(w * 5 + r) * 256 + col];
      if (ks == 0) s += p.b_mod[cc * 256 + col];
      MODP[(size_t)(ks * 5 + r) * NMODC + cc * 256 + col] = s; }
    __syncthreads();
  }
}
__device__ __forceinline__ float modsum(const float* MODP, int r, int idx) { float s = 0.f;
#pragma unroll
  for (int ks = 0; ks < KSPLIT; ++ks) s += MODP[(size_t)(ks * 5 + r) * NMODC + idx];
  return s; }

__device__ __forceinline__ void conv_tile(const float* src, int ldsrc, int sc0, bf16_t* dst, int K, int nd0, int k0, LAS unsigned char* lds) {
  LAS unsigned* T = (LAS unsigned*)lds;
  const int tid = threadIdx.x, nq = tid & 15, kp = tid >> 4;
#pragma unroll
  for (int pass = 0; pass < 2; ++pass) {
    const int kk = (pass * 32 + kp) * 2;
    const float* s0 = src + (size_t)(k0 + kk) * ldsrc + sc0 + nq * 4;
    const f32x4 a = __builtin_nontemporal_load((const f32x4*)s0), b = __builtin_nontemporal_load((const f32x4*)(s0 + ldsrc));
#pragma unroll
    for (int j = 0; j < 4; ++j) T[(nq * 4 + j) * 65 + pass * 32 + kp] = cvt_pk_bf16(a[j], b[j]);
  }
  __syncthreads();
  { const int row = tid >> 3, seg = tid & 7; u32x4 w0, w1;
    w0.x = T[row * 65 + seg * 8 + 0]; w0.y = T[row * 65 + seg * 8 + 1]; w0.z = T[row * 65 + seg * 8 + 2]; w0.w = T[row * 65 + seg * 8 + 3];
    w1.x = T[row * 65 + seg * 8 + 4]; w1.y = T[row * 65 + seg * 8 + 5]; w1.z = T[row * 65 + seg * 8 + 6]; w1.w = T[row * 65 + seg * 8 + 7];
    bf16_t* d = dst + (size_t)(nd0 + row) * K + k0 + seg * 16;
    *(u32x4*)d = w0; *(u32x4*)(d + 8) = w1; }
  __syncthreads();
}
__device__ __forceinline__ void conv_job(const float* src, int ldsrc, bf16_t* dst, int K, int ngroups, int map, int& tbase, LAS unsigned char* lds) {
  const int nk = K >> 7, nt = ngroups * nk, G = (int)gridDim.x;
  int t = ((int)blockIdx.x - (tbase % G) + G) % G;
  for (; t < nt; t += G) {
    const int ng = t / nk, kt = t - ng * nk, nd0 = ng * 64; int sc0;
    if (map == 0) sc0 = nd0;
    else if (map == 1) sc0 = ((nd0 & 255) >> 7) * DFF + (nd0 >> 8) * 128 + (nd0 & 127);
    else if (map == 2) sc0 = nd0 < 4096 ? 3072 + nd0 : 9216 + (nd0 - 4096);
    else sc0 = nd0 < 3072 ? nd0 : (nd0 < 5120 ? 7168 + (nd0 - 3072) : 9248 + (nd0 - 5120));
    conv_tile(src, ldsrc, sc0, dst, K, nd0, kt * 128, lds);
  }
  tbase += nt;
}

__device__ __forceinline__ void conv_queue(const Params& p, int q, LAS unsigned char* lds) {
  LAS unsigned* slot = (LAS unsigned*)(lds + 20480);
  unsigned* counter = (unsigned*)(p.ws + OFF_BAR) + 3456 + 64 + 64 * q;
  const int total = q == 0 ? 3584 : 4224;
  for (;;) {
    if (threadIdx.x == 0) slot[0] = __hip_atomic_fetch_add(counter, 1u, __ATOMIC_RELAXED, __HIP_MEMORY_SCOPE_AGENT);
    __syncthreads();
    int t = (int)slot[0];
    __syncthreads();
    if (t >= total) break;
    const float* src; bf16_t* dst; int ldsrc, K, map;
    if (q == 0) {
      if (t < 2304) { src = p.w_in; dst = (bf16_t*)(p.ws + OFF_WPB); ldsrc = DIN; K = DM; map = 3; }
      else if (t < 2560) { t -= 2304; src = p.conv_out; dst = (bf16_t*)(p.ws + OFF_WCO); ldsrc = DM; K = CONVW; map = 0; }
      else if (t < 3072) { t -= 2560; src = p.gla_out; dst = (bf16_t*)(p.ws + OFF_WGO); ldsrc = DM; K = DM; map = 0; }
      else { t -= 3072; src = p.w_o; dst = (bf16_t*)(p.ws + OFF_WO); ldsrc = DM; K = DM; map = 0; }
    } else {
      if (t < 2816) { src = p.ffn2_w_in; dst = (bf16_t*)(p.ws + OFF_W1IN); ldsrc = 2 * DFF; K = DM; map = 1; }
      else { t -= 2816; src = p.ffn2_w_out; dst = (bf16_t*)(p.ws + OFF_W1OUT); ldsrc = DM; K = DFF; map = 0; }
    }
    const int nk = K >> 7, ng = t / nk, kt = t - ng * nk, nd0 = ng * 64; int sc0;
    if (map == 0) sc0 = nd0;
    else if (map == 1) sc0 = ((nd0 & 255) >> 7) * DFF + (nd0 >> 8) * 128 + (nd0 & 127);
    else sc0 = nd0 < 3072 ? nd0 : (nd0 < 5120 ? 7168 + (nd0 - 3072) : 9248 + (nd0 - 5120));
    conv_tile(src, ldsrc, sc0, dst, K, nd0, kt * 128, lds);
  }
}

__device__ __forceinline__ void rows_norm_mod(const float* xsrc, bf16_t* udst, int nrows, const LAS float* Av, const LAS float* Bv) {
  const int wid = threadIdx.x >> 6, lane = threadIdx.x & 63;
  for (int row = blockIdx.x * 8 + wid; row < nrows; row += gridDim.x * 8) {
    const float* xr = xsrc + (size_t)row * DM; f32x4 v[8]; float ss = 0.f;
#pragma unroll
    for (int i = 0; i < 8; ++i) { v[i] = __builtin_nontemporal_load((const f32x4*)(xr + (i * 64 + lane) * 4)); ss += v[i][0] * v[i][0] + v[i][1] * v[i][1] + v[i][2] * v[i][2] + v[i][3] * v[i][3]; }
    ss = wave_sum(ss); const float rs = rsqrtf(ss * (1.0f / DM) + EPS);
    bf16_t* ur = udst + (size_t)row * DM;
#pragma unroll
    for (int i = 0; i < 8; ++i) { const int c = (i * 64 + lane) * 4; const f32x4 a = *(const LAS f32x4*)(Av + c), b = *(const LAS f32x4*)(Bv + c); const f32x4 o = v[i] * rs * a + b;
      u32x2 w; w.x = cvt_pk_bf16(o[0], o[1]); w.y = cvt_pk_bf16(o[2], o[3]); *(u32x2*)(ur + c) = w; }
  }
}
template <bool HAS_U, bool YSPLIT = false>
__device__ __forceinline__ void rows_resid(const float* xsrc, const bf16_t* y, float* xdst, bf16_t* udst, int nrows, const LAS float* Gv, const LAS float* Av, const LAS float* Bv) {
  const int wid = threadIdx.x >> 6, lane = threadIdx.x & 63;
  for (int row = blockIdx.x * 8 + wid; row < nrows; row += gridDim.x * 8) {
    const bf16_t* yr = y + (size_t)row * DM; const float* xr = xsrc + (size_t)row * DM; f32x4 v[8]; float ss = 0.f;
#pragma unroll
    for (int i = 0; i < 8; ++i) {
      if (YSPLIT) { const float* yf = (const float*)y + (size_t)row * DM + (i * 64 + lane) * 4; v[i] = *(const f32x4*)yf + *(const f32x4*)(yf + (size_t)MC * DM) + *(const f32x4*)(yf + 2 * (size_t)MC * DM) + *(const f32x4*)(yf + 3 * (size_t)MC * DM); }
      else { const u32x2 yw = __builtin_nontemporal_load((const u32x2*)(y + ((size_t)((row >> 8) * 8 + i) << 16) + (row & 255) * 256 + lane * 4)); v[i] = (f32x4){bf_lo(yw.x), bf_hi(yw.x), bf_lo(yw.y), bf_hi(yw.y)}; } ss += v[i][0] * v[i][0] + v[i][1] * v[i][1] + v[i][2] * v[i][2] + v[i][3] * v[i][3]; }
    ss = wave_sum(ss); const float rs = rsqrtf(ss * (1.0f / DM) + EPS);
    float s2 = 0.f; float* xo = xdst + (size_t)row * DM;
#pragma unroll
    for (int i = 0; i < 8; ++i) { const int c = (i * 64 + lane) * 4; const f32x4 g = *(const LAS f32x4*)(Gv + c); const f32x4 xv = __builtin_nontemporal_load((const f32x4*)(xr + c));
      v[i] = xv + v[i] * rs * g; __builtin_nontemporal_store(v[i], (f32x4*)(xo + c)); s2 += v[i][0] * v[i][0] + v[i][1] * v[i][1] + v[i][2] * v[i][2] + v[i][3] * v[i][3]; }
    if (HAS_U) {
      s2 = wave_sum(s2); const float r2 = rsqrtf(s2 * (1.0f / DM) + EPS); bf16_t* ur = udst + (size_t)row * DM;
#pragma unroll
      for (int i = 0; i < 8; ++i) { const int c = (i * 64 + lane) * 4; const f32x4 a = *(const LAS f32x4*)(Av + c), b = *(const LAS f32x4*)(Bv + c); const f32x4 o = v[i] * r2 * a + b;
        u32x2 w; w.x = cvt_pk_bf16(o[0], o[1]); w.y = cvt_pk_bf16(o[2], o[3]); *(u32x2*)(ur + c) = w; }
    }
  }
}
__device__ __forceinline__ void fill_vecs(const Params& p, int r, int mg, float gscale, int ng_post, int ng_pre, int msc, int msh, LAS float* Gv, LAS float* Av, LAS float* Bv) {
  const float* MODP = (const float*)(p.ws + OFF_MODP);
  for (int c = threadIdx.x; c < DM; c += 512) {
    if (mg >= 0) Gv[c] = gscale * modsum(MODP, r, mg * DM + c) * p.norm_g[ng_post * DM + c];
    if (ng_pre >= 0) { Av[c] = p.norm_g[ng_pre * DM + c] * (1.0f + modsum(MODP, r, msc * DM + c)); Bv[c] = modsum(MODP, r, msh * DM + c); }
  }
}

__device__ __forceinline__ void unpack8(const u32x4 w, float (&f)[8]) { f[0] = bf_lo(w.x); f[1] = bf_hi(w.x); f[2] = bf_lo(w.y); f[3] = bf_hi(w.y); f[4] = bf_lo(w.z); f[5] = bf_hi(w.z); f[6] = bf_lo(w.w); f[7] = bf_hi(w.w); }
__device__ __forceinline__ void phase_prep(const Params& p, LAS unsigned char* lds) {
  constexpr int BCS = 260;
  LAS float* Bc = (LAS float*)lds;
  LAS float* lol = (LAS float*)(lds + 66560);
  LAS float* Tt = (LAS float*)(lds + 70656);
  LAS float* Hs = (LAS float*)(lds + 71680);
  LAS unsigned char* Ql = lds + 73728;
  LAS unsigned char* Kd = lds + 73728 + 33792;
  const bf16_t* Q = (const bf16_t*)(p.ws + OFF_Q); const bf16_t* Kg = (const bf16_t*)(p.ws + OFF_K); const float* LO = (const float*)(p.ws + OFF_LO);
  bf16_t* QD = (bf16_t*)(p.ws + OFF_QD); bf16_t* KDT = (bf16_t*)(p.ws + OFF_KDT); bf16_t* PS = (bf16_t*)(p.ws + OFF_PS); float* AL = (float*)(p.ws + OFF_AL);
  const int tid = threadIdx.x, wid = tid >> 6, lane = tid & 63, fr = lane & 15, fq = lane >> 4;
  for (int wi = blockIdx.x; wi < 272 * 8; wi += gridDim.x) {
    const int item = wi >> 1, dir = wi & 1, gid = item >> 2, h = item & 3, row0 = gid * 64; const bool is_ctx = gid >= 256;
    const size_t itd = (size_t)wi;
    u32x4 rq[4], rk[4];
#pragma unroll
    for (int j = 0; j < 4; ++j) { const int v = tid + 512 * j, i = v >> 5, k8 = (v & 31) * 8;
      const size_t qoff = ((size_t)((gid >> 2) * 4 + h) << 16) + (size_t)((gid & 3) * 64 + i) * 256 + k8;
      rk[j] = *(const u32x4*)(Kg + qoff);
      rq[j] = is_ctx ? (u32x4){0, 0, 0, 0} : *(const u32x4*)(Q + qoff); }
    if (tid < 256) { const int i = tid >> 2, j4 = (tid & 3) * 4; *(LAS f32x4*)(lol + i * 16 + j4) = *(const f32x4*)(LO + (size_t)(row0 + i) * 32 + dir * 16 + j4); }
    __syncthreads();
    {
      const int half = tid >> 8, col = tid & 255, kk = h * 256 + col; float up[16];
#pragma unroll
      for (int r = 0; r < 16; ++r) up[r] = p.gate_up[(size_t)(dir * 16 + r) * 1024 + kk];
      const float bias = p.gate_bias[dir * 1024 + kk]; float la[32]; float tot = 0.f;
#pragma unroll
      for (int ii = 0; ii < 32; ++ii) { const int i = half * 32 + ii; float z = bias;
#pragma unroll
        for (int r4 = 0; r4 < 4; ++r4) { const f32x4 l = *(const LAS f32x4*)(lol + i * 16 + r4 * 4); z += l[0] * up[r4 * 4] + l[1] * up[r4 * 4 + 1] + l[2] * up[r4 * 4 + 2] + l[3] * up[r4 * 4 + 3]; }
        la[ii] = (fminf(z, 0.f) - __logf(1.0f + __expf(-fabsf(z)))) * (1.0f / 16.0f); tot += la[ii]; }
      Hs[half * 256 + col] = tot;
      __syncthreads();
      float run = half ? Hs[col] : 0.f;
#pragma unroll
      for (int ii = 0; ii < 32; ++ii) { const int i = half * 32 + ii; if (dir == 0) { run += la[ii]; Bc[i * BCS + col] = run; } else { Bc[i * BCS + col] = run; run += la[ii]; } }
      if (half) { Tt[col] = run; AL[itd * 256 + col] = __expf(run); }
    }
    __syncthreads();
#pragma unroll
    for (int j = 0; j < 4; ++j) { const int v = tid + 512 * j, i = v >> 5, k8 = (v & 31) * 8; float q[8], kv[8]; unpack8(rq[j], q); unpack8(rk[j], kv);
      const f32x4 x0 = *(const LAS f32x4*)(Bc + i * BCS + k8), x1 = *(const LAS f32x4*)(Bc + i * BCS + k8 + 4), t0 = *(const LAS f32x4*)(Tt + k8), t1 = *(const LAS f32x4*)(Tt + k8 + 4);
      float oq[8], ok[8], op[8];
#pragma unroll
      for (int e = 0; e < 8; ++e) { const float x = e < 4 ? x0[e & 3] : x1[e & 3], T = e < 4 ? t0[e & 3] : t1[e & 3];
        const float eq = __expf(dir == 0 ? x : T - x), ek = __expf(dir == 0 ? T - x : x); const float qs = q[e] * 0.0625f;
        oq[e] = qs * eq; ok[e] = kv[e] * ek; op[e] = qs * __builtin_amdgcn_rcpf(ek); }
      u32x4 w;
      if (!is_ctx) { w.x = cvt_pk_bf16(oq[0], oq[1]); w.y = cvt_pk_bf16(oq[2], oq[3]); w.z = cvt_pk_bf16(oq[4], oq[5]); w.w = cvt_pk_bf16(oq[6], oq[7]);
        *(u32x4*)(QD + itd * 16384 + i * 256 + k8) = w;
        w.x = cvt_pk_bf16(op[0], op[1]); w.y = cvt_pk_bf16(op[2], op[3]); w.z = cvt_pk_bf16(op[4], op[5]); w.w = cvt_pk_bf16(op[6], op[7]);
        *(LAS u32x4*)(Ql + i * 528 + k8 * 2) = w; }
      w.x = cvt_pk_bf16(ok[0], ok[1]); w.y = cvt_pk_bf16(ok[2], ok[3]); w.z = cvt_pk_bf16(ok[4], ok[5]); w.w = cvt_pk_bf16(ok[6], ok[7]);
      *(LAS u32x4*)(Kd + i * 528 + k8 * 2) = w; }
    __syncthreads();
#pragma unroll
    for (int j = 0; j < 4; ++j) { const int v = tid + 512 * j, k = v >> 3, s8 = (v & 7) * 8; unsigned short o[8];
#pragma unroll
      for (int e = 0; e < 8; ++e) o[e] = *(const LAS unsigned short*)(Kd + (s8 + e) * 528 + k * 2);
      u32x4 w; w.x = (unsigned)o[0] | ((unsigned)o[1] << 16); w.y = (unsigned)o[2] | ((unsigned)o[3] << 16); w.z = (unsigned)o[4] | ((unsigned)o[5] << 16); w.w = (unsigned)o[6] | ((unsigned)o[7] << 16);
      *(u32x4*)(KDT + itd * 16384 + k * 64 + s8) = w; }
    if (!is_ctx) {
      const int cb = wid >> 1, sb0 = (wid & 1) * 2; f32x4 acc[2] = {{0, 0, 0, 0}, {0, 0, 0, 0}};
#pragma unroll
      for (int ks = 0; ks < 8; ++ks) { const bf16x8 qf = *(const LAS bf16x8*)(Ql + (cb * 16 + fr) * 528 + (ks * 32 + fq * 8) * 2);
#pragma unroll
        for (int t = 0; t < 2; ++t) { const bf16x8 kf = *(const LAS bf16x8*)(Kd + ((sb0 + t) * 16 + fr) * 528 + (ks * 32 + fq * 8) * 2); acc[t] = __builtin_amdgcn_mfma_f32_16x16x32_bf16(kf, qf, acc[t], 0, 0, 0); } }
      const int c = cb * 16 + fr;
#pragma unroll
      for (int t = 0; t < 2; ++t) { const int s0 = (sb0 + t) * 16 + fq * 4; float o[4];
#pragma unroll
        for (int r = 0; r < 4; ++r) { const int s = s0 + r; const bool keep = dir == 0 ? (s <= c) : (s >= c); o[r] = keep ? acc[t][r] : 0.f; }
        u32x2 w; w.x = cvt_pk_bf16(o[0], o[1]); w.y = cvt_pk_bf16(o[2], o[3]); *(u32x2*)(PS + itd * 4096 + c * 64 + s0) = w; }
    }
    __syncthreads();
  }
}

__device__ __forceinline__ void phase_chain(const Params& p, LAS unsigned char* lds, int vb) {
  constexpr int KDT_O = 0, VT_O = 36864, PS_O = VT_O + 9216, QD_O = PS_O + 9216, SB_O = QD_O + 33792, AL_O = SB_O + 33792;
  const bf16_t* QD = (const bf16_t*)(p.ws + OFF_QD); const bf16_t* KDT = (const bf16_t*)(p.ws + OFF_KDT); const bf16_t* PS = (const bf16_t*)(p.ws + OFF_PS);
  const bf16_t* VT = (const bf16_t*)(p.ws + OFF_VT); const float* AL = (const float*)(p.ws + OFF_AL);
  const int tid = threadIdx.x, wid = __builtin_amdgcn_readfirstlane(tid >> 6), lane = tid & 63, fr = lane & 15, fq = lane >> 4;
  for (int cid = vb; cid < 256; cid += gridDim.x) {
    const int xcd = cid & 7, w = cid >> 3, vs = w & 7, bhd = xcd * 4 + (w >> 3), b = bhd >> 3, h = (bhd >> 1) & 3, dir = bhd & 1;
    bf16_t* O = (bf16_t*)(p.ws + (dir ? OFF_OB : OFF_OF));
    f32x4 S[2][4];
#pragma unroll
    for (int a = 0; a < 2; ++a)
#pragma unroll
      for (int v = 0; v < 4; ++v) S[a][v] = (f32x4){0.f, 0.f, 0.f, 0.f};
    u32x4 rk[4], rq[4], rv, rp; float ra = 0.f;
#pragma unroll
    for (int j = 0; j < 4; ++j) rq[j] = (u32x4){0, 0, 0, 0};
    rp = (u32x4){0, 0, 0, 0};
#define CH_GID(st) ((st) < 4 ? 256 + b * 4 + (dir ? 3 - (st) : (st)) : b * 64 + (dir ? 67 - (st) : (st) - 4))
#define CH_LOAD(st) do { const int gid_ = CH_GID(st); const size_t it_ = ((size_t)gid_ * 4 + h) * 2 + dir; \
      _Pragma("unroll") for (int j = 0; j < 4; ++j) rk[j] = *(const u32x4*)(KDT + it_ * 16384 + (size_t)(tid + 512 * j) * 8); \
      rv = *(const u32x4*)(VT + ((size_t)gid_ * 2048 + h * 512 + vs * 64) * 64 + (size_t)tid * 8); \
      if ((st) >= 4) { _Pragma("unroll") for (int j = 0; j < 4; ++j) rq[j] = *(const u32x4*)(QD + it_ * 16384 + (size_t)(tid + 512 * j) * 8); rp = *(const u32x4*)(PS + it_ * 4096 + (size_t)tid * 8); } \
      if (tid < 256) ra = AL[it_ * 256 + tid]; } while (0)
    CH_LOAD(0);
    for (int st = 0; st < 68; ++st) {
      const bool latent = st >= 4;
#pragma unroll
      for (int j = 0; j < 4; ++j) { const int v = tid + 512 * j; *(LAS u32x4*)(lds + KDT_O + (v >> 3) * 144 + (v & 7) * 16) = rk[j]; }
      *(LAS u32x4*)(lds + VT_O + (tid >> 3) * 144 + (tid & 7) * 16) = rv;
      if (latent) {
#pragma unroll
        for (int j = 0; j < 4; ++j) { const int v = tid + 512 * j; *(LAS u32x4*)(lds + QD_O + (v >> 5) * 528 + (v & 31) * 16) = rq[j]; }
        *(LAS u32x4*)(lds + PS_O + (tid >> 3) * 144 + (tid & 7) * 16) = rp;
#pragma unroll
        for (int a = 0; a < 2; ++a)
#pragma unroll
          for (int vb = 0; vb < 4; ++vb) { u32x2 wv; wv.x = cvt_pk_bf16(S[a][vb][0], S[a][vb][1]); wv.y = cvt_pk_bf16(S[a][vb][2], S[a][vb][3]);
            *(LAS u32x2*)(lds + SB_O + (vb * 16 + fr) * 528 + ((2 * wid + a) * 16 + fq * 4) * 2) = wv; }
      }
      if (tid < 256) *(LAS float*)(lds + AL_O + tid * 4) = ra;
      __syncthreads();
      const int gid = CH_GID(st);
      if (st + 1 < 68) CH_LOAD(st + 1);
      if (latent) {
        const int cb = wid >> 1, vb0 = (wid & 1) * 2; f32x4 o[2] = {{0, 0, 0, 0}, {0, 0, 0, 0}};
#pragma unroll
        for (int ks = 0; ks < 2; ++ks) { const bf16x8 pf = *(const LAS bf16x8*)(lds + PS_O + (cb * 16 + fr) * 144 + (ks * 32 + fq * 8) * 2);
#pragma unroll
          for (int t = 0; t < 2; ++t) { const bf16x8 vf = *(const LAS bf16x8*)(lds + VT_O + ((vb0 + t) * 16 + fr) * 144 + (ks * 32 + fq * 8) * 2); o[t] = __builtin_amdgcn_mfma_f32_16x16x32_bf16(vf, pf, o[t], 0, 0, 0); } }
#pragma unroll
        for (int ks = 0; ks < 8; ++ks) { const bf16x8 qf = *(const LAS bf16x8*)(lds + QD_O + (cb * 16 + fr) * 528 + (ks * 32 + fq * 8) * 2);
#pragma unroll
          for (int t = 0; t < 2; ++t) { const bf16x8 sf = *(const LAS bf16x8*)(lds + SB_O + ((vb0 + t) * 16 + fr) * 528 + (ks * 32 + fq * 8) * 2); o[t] = __builtin_amdgcn_mfma_f32_16x16x32_bf16(sf, qf, o[t], 0, 0, 0); } }
        const size_t row = (size_t)gid * 64 + cb * 16 + fr;
#pragma unroll
        for (int t = 0; t < 2; ++t) { u32x2 wv; wv.x = cvt_pk_bf16(o[t][0], o[t][1]); wv.y = cvt_pk_bf16(o[t][2], o[t][3]); __builtin_nontemporal_store(wv, (u32x2*)(O + row * 2048 + h * 512 + vs * 64 + (vb0 + t) * 16 + fq * 4)); }
      }
#pragma unroll
      for (int a = 0; a < 2; ++a) {
        const f32x4 al = *(const LAS f32x4*)(lds + AL_O + ((2 * wid + a) * 16 + fq * 4) * 4);
        bf16x8 kf[2];
#pragma unroll
        for (int ks = 0; ks < 2; ++ks) kf[ks] = *(const LAS bf16x8*)(lds + KDT_O + ((2 * wid + a) * 16 + fr) * 144 + (ks * 32 + fq * 8) * 2);
#pragma unroll
        for (int vb = 0; vb < 4; ++vb) { S[a][vb] *= al;
#pragma unroll
          for (int ks = 0; ks < 2; ++ks) { const bf16x8 vf = *(const LAS bf16x8*)(lds + VT_O + (vb * 16 + fr) * 144 + (ks * 32 + fq * 8) * 2); S[a][vb] = __builtin_amdgcn_mfma_f32_16x16x32_bf16(kf[ks], vf, S[a][vb], 0, 0, 0); } }
      }
      __syncthreads();
    }
#undef CH_LOAD
#undef CH_GID
  }
}

__device__ __forceinline__ void phase_mix_elem(const Params& p) {
  const bf16_t* PBc = (const bf16_t*)(p.ws + OFF_PBC); const bf16_t* PBr = (const bf16_t*)(p.ws + OFF_PBR);
  const bf16_t* OF = (const bf16_t*)(p.ws + OFF_OF); const bf16_t* OB = (const bf16_t*)(p.ws + OFF_OB);
  bf16_t* AC = (bf16_t*)(p.ws + OFF_ACONV); bf16_t* AG = (bf16_t*)(p.ws + OFF_AGLA);
  const int wid = threadIdx.x >> 6, lane = threadIdx.x & 63;
  for (int row = blockIdx.x * 8 + wid; row < ML; row += gridDim.x * 8) {
    const int gc = row & 63; const bool hasl = gc != 0, hasr = gc != 63;
#pragma unroll
    for (int half = 0; half < 2; ++half) {
      const int c = half * 512 + lane * 8; float zc[8], zl[8], zr[8], t0[8], t1[8], bg[8];
      const bf16_t* pr = PBc + ((size_t)((row >> 8) * 12 + (c >> 8)) << 16) + (row & 255) * 256 + (c & 255);
      constexpr int TC = 4 << 16, TH = 8 << 16;
      unpack8(*(const u32x4*)(pr + TC), t0); unpack8(*(const u32x4*)(pr + TH), t1);
#pragma unroll
      for (int e = 0; e < 8; ++e) zc[e] = t0[e] * t1[e];
      if (hasl) { unpack8(*(const u32x4*)(pr - 256 + TC), t0); unpack8(*(const u32x4*)(pr - 256 + TH), t1);
#pragma unroll
        for (int e = 0; e < 8; ++e) zl[e] = t0[e] * t1[e]; } else {
#pragma unroll
        for (int e = 0; e < 8; ++e) zl[e] = 0.f; }
      if (hasr) { unpack8(*(const u32x4*)(pr + 256 + TC), t0); unpack8(*(const u32x4*)(pr + 256 + TH), t1);
#pragma unroll
        for (int e = 0; e < 8; ++e) zr[e] = t0[e] * t1[e]; } else {
#pragma unroll
        for (int e = 0; e < 8; ++e) zr[e] = 0.f; }
      unpack8(*(const u32x4*)pr, bg);
      float o[8];
#pragma unroll
      for (int e = 0; e < 8; ++e) o[e] = bg[e] * (p.conv_w[c + e] * zl[e] + p.conv_w[1024 + c + e] * zc[e] + p.conv_w[2048 + c + e] * zr[e] + p.conv_b[c + e]);
      u32x4 w; w.x = cvt_pk_bf16(o[0], o[1]); w.y = cvt_pk_bf16(o[2], o[3]); w.z = cvt_pk_bf16(o[4], o[5]); w.w = cvt_pk_bf16(o[6], o[7]);
      *(u32x4*)(AC + (size_t)row * 1024 + c) = w;
    }
#pragma unroll
    for (int h = 0; h < 4; ++h) {
      const int c = h * 512 + lane * 8; float a[8], b[8], r[8], o[8]; float ss = 0.f;
      unpack8(__builtin_nontemporal_load((const u32x4*)(OF + (size_t)row * 2048 + c)), a); unpack8(__builtin_nontemporal_load((const u32x4*)(OB + (size_t)row * 2048 + c)), b); unpack8(*(const u32x4*)(PBr + ((size_t)((row >> 8) * 8 + (c >> 8)) << 16) + (row & 255) * 256 + (c & 255)), r);
#pragma unroll
      for (int e = 0; e < 8; ++e) { a[e] += b[e]; ss += a[e] * a[e]; }
      ss = wave_sum(ss); const float rs = rsqrtf(ss * (1.0f / HV) + EPS);
#pragma unroll
      for (int e = 0; e < 8; ++e) o[e] = a[e] * rs * p.gla_norm_g[c + e] * fsilu(r[e]);
      u32x4 w; w.x = cvt_pk_bf16(o[0], o[1]); w.y = cvt_pk_bf16(o[2], o[3]); w.z = cvt_pk_bf16(o[4], o[5]); w.w = cvt_pk_bf16(o[6], o[7]);
      *(u32x4*)(AG + (size_t)row * 2048 + c) = w;
    }
  }
}


#define XB_TMO      128
#define XB_XCNT(j)  (256  + 64 * (j))
#define XB_XSUB(j)  (1280 + 64 * (j))
#define XB_XGEN(j)  (2304 + 64 * (j))
#define XB_TOP      3328
#define XB_TOPGEN   3392
#define XCD_BAR_WORDS 3456
#define XB_SPIN_CAP (1u << 18)
__device__ __forceinline__ unsigned xb_ld(unsigned* p)              { return __hip_atomic_load(p, __ATOMIC_RELAXED, __HIP_MEMORY_SCOPE_AGENT); }
__device__ __forceinline__ unsigned xb_add(unsigned* p, unsigned v) { return __hip_atomic_fetch_add(p, v, __ATOMIC_RELAXED, __HIP_MEMORY_SCOPE_AGENT); }
__device__ __forceinline__ unsigned xb_xcc_id() { return (unsigned)__builtin_amdgcn_s_getreg((3 << 11) | 20) & 0xFu; }
#define XB_SPIN(cond, bar) do { unsigned _sp = 0; while (cond) { __builtin_amdgcn_s_sleep(1); \
    if ((++_sp & 255u) == 0u) { if (xb_ld(&(bar)[XB_TMO])) break; if (_sp > XB_SPIN_CAP) { atomicAdd(&(bar)[XB_TMO], 1u); break; } } } } while (0)
struct XcdBarrier { unsigned* bar; unsigned x; volatile LAS unsigned* st; };
__device__ __forceinline__ XcdBarrier xcd_barrier_post(unsigned* bar, volatile LAS unsigned* st) {
    XcdBarrier b; b.bar = bar; b.x = xb_xcc_id(); b.st = st;
    if (threadIdx.x == 0) st[2] = xb_add(&bar[XB_XCNT(b.x)], 1u);
    return b;
}
__device__ __forceinline__ void xcd_barrier_complete(unsigned* bar, unsigned x, unsigned& nloc, unsigned& nx) {
    const unsigned G = gridDim.x * gridDim.y * gridDim.z;
    unsigned sum, cnt, mine, sp = 0u;
    for (;;) {
        sum = 0u; cnt = 0u; mine = 0u;
#pragma unroll
        for (unsigned j = 0; j < 16; ++j) { const unsigned c = xb_ld(&bar[XB_XCNT(j)]); sum += c; cnt += (c > 0u) ? 1u : 0u; mine = (j == x) ? c : mine; }
        if (sum == G) break;
        __builtin_amdgcn_s_sleep(1);
        if ((++sp & 255u) == 0u) { if (xb_ld(&bar[XB_TMO])) break; if (sp > XB_SPIN_CAP) { atomicAdd(&bar[XB_TMO], 1u); break; } }
    }
    nloc = mine > 0u ? mine : 1u; nx = cnt > 0u ? cnt : 1u;
}
__device__ __forceinline__ void xcd_barrier(const XcdBarrier& b) {
    asm volatile("s_waitcnt vmcnt(0)" ::: "memory");
    __syncthreads();
    if (threadIdx.x == 0) {
        unsigned* bar = b.bar;
        __builtin_amdgcn_s_waitcnt(0);
        unsigned nloc = b.st[0], nx = b.st[1];
        if (nloc == 0u) { xcd_barrier_complete(bar, b.x, nloc, nx); b.st[0] = nloc; b.st[1] = nx; }
        const unsigned old = xb_add(&bar[XB_XSUB(b.x)], 1u);
        const unsigned gen = old / nloc;
        if (old + 1u == (gen + 1u) * nloc) {
            __builtin_amdgcn_fence(__ATOMIC_RELEASE, "agent");
            asm volatile("s_waitcnt vmcnt(0)" ::: "memory");
            const unsigned og = xb_add(&bar[XB_TOP], 1u);
            const unsigned tg = og / nx;
            if (og + 1u == (tg + 1u) * nx) xb_add(&bar[XB_TOPGEN], 1u);
            else XB_SPIN(xb_ld(&bar[XB_TOPGEN]) == tg, bar);
            __builtin_amdgcn_fence(__ATOMIC_ACQUIRE, "agent");
            xb_add(&bar[XB_XGEN(b.x)], 1u);
            asm volatile("s_waitcnt vmcnt(0)" ::: "memory");
        } else {
            XB_SPIN(xb_ld(&bar[XB_XGEN(b.x)]) == gen, bar);
            __builtin_amdgcn_fence(__ATOMIC_ACQUIRE, "agent");
            asm volatile("s_waitcnt vmcnt(0)" ::: "memory");
        }
    }
    __syncthreads();
}

__global__ void __launch_bounds__(512, 2) mk_fwd(Params p) {
  extern __shared__ __attribute__((aligned(16))) unsigned char lds_raw[];
  LAS unsigned char* lds = (LAS unsigned char*)lds_raw;
  cg::grid_group grid = cg::this_grid();
  unsigned char* ws = p.ws;
  const int lo = p.ph_lo, hi = p.ph_hi;
#define IN(k) (lo <= (k) && (k) < hi)
#define SEAM(k) do { if (IN(k) && IN((k) + 1)) xcd_barrier(xbar); } while (0)
  volatile LAS unsigned* xst = (volatile LAS unsigned*)(lds + LDS_BYTES - 16);
  if (threadIdx.x == 0) { xst[0] = 0u; xst[1] = 0u; }
  __syncthreads();
  XcdBarrier xbar; xbar.bar = (unsigned*)(p.ws + OFF_BAR); xbar.x = 0; xbar.st = xst;
  if (hi - lo > 1) xbar = xcd_barrier_post((unsigned*)(p.ws + OFF_BAR), xst);
  if (hi < 0) grid.sync();
  LAS float* Gv = (LAS float*)lds; LAS float* Av = (LAS float*)(lds + 8192); LAS float* Bv = (LAS float*)(lds + 16384);
  bf16_t* U = (bf16_t*)(ws + OFF_U);

  if (IN(0)) {
    phase_mod(p, lds);
    int tb = 0;
    conv_job(p.ffn1_w_in, 2 * DFF, (bf16_t*)(ws + OFF_W1IN), DM, 176, 1, tb, lds);
    conv_job(p.w_in, DIN, (bf16_t*)(ws + OFF_WPA), DM, 65, 2, tb, lds);
    conv_job(p.ffn1_w_out, DM, (bf16_t*)(ws + OFF_W1OUT), DFF, 32, 0, tb, lds);
  }
  SEAM(0);
  int vb = (int)blockIdx.x;
  if (IN(0) && IN(1)) {
    if (threadIdx.x == 0) {
      unsigned* bar = (unsigned*)(p.ws + OFF_BAR); bool ok = (gridDim.x & 7u) == 0u; const unsigned per = gridDim.x >> 3;
      for (unsigned j = 0; j < 16; ++j) { const unsigned c = xb_ld(&bar[XB_XCNT(j)]); if (j < 8 ? c != per : c != 0u) ok = false; }
      xst[3] = ok ? xst[2] * 8u + xbar.x : blockIdx.x;
    }
    __syncthreads();
    vb = (int)xst[3];
  }
  if (IN(1)) {
    for (int r = 0; r < 5; ++r) {
      fill_vecs(p, r, -1, 0.f, 0, 0, 1, 0, Gv, Av, Bv); __syncthreads();
      if (r < 4) rows_norm_mod(p.x + (size_t)r * SEQ * DM, U + (size_t)r * SEQ * DM, SEQ, Av, Bv);
      else rows_norm_mod(p.ctx, U + (size_t)ML * DM, MC, Av, Bv);
      __syncthreads();
    }
  }
  SEAM(1);
  if (IN(2)) { EpiSwiglu E{(bf16_t*)(ws + OFF_ACT)}; run_gemm_v(vb, lds, U, (const bf16_t*)(ws + OFF_W1IN), MT, 2 * DFF, DM, E); __syncthreads(); conv_queue(p, 0, lds); }
  SEAM(2);
  if (IN(3)) {
    { EpiBf16 E{(bf16_t*)(ws + OFF_Y), 8}; run_gemm_v(vb, lds, (const bf16_t*)(ws + OFF_ACT), (const bf16_t*)(ws + OFF_W1OUT), ML, DM, DFF, E); }
    { EpiF32Split E{(float*)(ws + OFF_YC), DM, (size_t)MC * DM}; run_gemm_v(vb, lds, (const bf16_t*)(ws + OFF_ACT) + (size_t)ML * DFF, (const bf16_t*)(ws + OFF_W1OUT), MC, DM, DFF, E, 4); }
    __syncthreads(); conv_queue(p, 0, lds);
  }
  SEAM(3);
  if (IN(4)) {
    conv_queue(p, 0, lds);
    const bf16_t* Y = (const bf16_t*)(ws + OFF_Y);
    for (int r = 0; r < 5; ++r) {
      fill_vecs(p, r, 2, 0.5f, 1, 2, 4, 3, Gv, Av, Bv); __syncthreads();
      if (r < 4) rows_resid<true>(p.x + (size_t)r * SEQ * DM, Y + (size_t)r * SEQ * DM, p.out + (size_t)r * SEQ * DM, U + (size_t)r * SEQ * DM, SEQ, Gv, Av, Bv);
      else rows_resid<true, true>(p.ctx, (const bf16_t*)(ws + OFF_YC), (float*)(ws + OFF_CX1), U + (size_t)ML * DM, MC, Gv, Av, Bv);
      __syncthreads();
    }
  }
  SEAM(4);
  if (IN(5)) { EpiPA E{(bf16_t*)(ws + OFF_Q), (bf16_t*)(ws + OFF_K), (bf16_t*)(ws + OFF_VT), (float*)(ws + OFF_LO)}; run_gemm_v(vb, lds, U, (const bf16_t*)(ws + OFF_WPA), MT, 4352, DM, E); __syncthreads(); conv_queue(p, 1, lds); }
  SEAM(5);
  if (IN(6)) phase_prep(p, lds);
  SEAM(6);
  if (IN(7)) phase_chain(p, lds, vb);
  SEAM(7);
  if (IN(8)) { EpiPB E{(bf16_t*)(ws + OFF_PBC), (bf16_t*)(ws + OFF_PBR), (bf16_t*)(ws + OFF_PBG)}; run_gemm_v(vb, lds, U, (const bf16_t*)(ws + OFF_WPB), ML, 9216, DM, E); }
  SEAM(8);
  if (IN(9)) { conv_queue(p, 1, lds); phase_mix_elem(p); }
  SEAM(9);
  if (IN(10)) { EpiGateT E{(const bf16_t*)(ws + OFF_PBG), (bf16_t*)(ws + OFF_T)}; run_gemm_v(vb, lds, (const bf16_t*)(ws + OFF_ACONV), (const bf16_t*)(ws + OFF_WCO), ML, DM, CONVW, E); }
  if (IN(10) && IN(11)) { asm volatile("s_waitcnt vmcnt(0)" ::: "memory"); __syncthreads(); }
  if (IN(11)) { EpiGateZ E{(const bf16_t*)(ws + OFF_PBG), (const bf16_t*)(ws + OFF_T), (bf16_t*)(ws + OFF_Z)}; run_gemm_v(vb, lds, (const bf16_t*)(ws + OFF_AGLA), (const bf16_t*)(ws + OFF_WGO), ML, DM, DM, E); }
  SEAM(11);
  if (IN(12)) { EpiBf16 E{(bf16_t*)(ws + OFF_Y2), 8}; run_gemm_v(vb, lds, (const bf16_t*)(ws + OFF_Z), (const bf16_t*)(ws + OFF_WO), ML, DM, DM, E); }
  SEAM(12);
  if (IN(13)) {
    const bf16_t* Y = (const bf16_t*)(ws + OFF_Y2);
    for (int r = 0; r < 4; ++r) {
      fill_vecs(p, r, 5, 1.0f, 3, 4, 7, 6, Gv, Av, Bv); __syncthreads();
      rows_resid<true>(p.out + (size_t)r * SEQ * DM, Y + (size_t)r * SEQ * DM, p.out + (size_t)r * SEQ * DM, U + (size_t)r * SEQ * DM, SEQ, Gv, Av, Bv);
      __syncthreads();
    }
  }
  SEAM(13);
  if (IN(14)) { EpiSwiglu E{(bf16_t*)(ws + OFF_ACT)}; run_gemm_v(vb, lds, U, (const bf16_t*)(ws + OFF_W1IN), ML, 2 * DFF, DM, E); }
  SEAM(14);
  if (IN(15)) { EpiBf16 E{(bf16_t*)(ws + OFF_Y), 8}; run_gemm_v(vb, lds, (const bf16_t*)(ws + OFF_ACT), (const bf16_t*)(ws + OFF_W1OUT), ML, DM, DFF, E); }
  SEAM(15);
  if (IN(16)) {
    const bf16_t* Y = (const bf16_t*)(ws + OFF_Y);
    for (int r = 0; r < 4; ++r) {
      fill_vecs(p, r, 8, 0.5f, 5, -1, 0, 0, Gv, Av, Bv); __syncthreads();
      rows_resid<false>(p.out + (size_t)r * SEQ * DM, Y + (size_t)r * SEQ * DM, p.out + (size_t)r * SEQ * DM, nullptr, SEQ, Gv, Av, Bv);
      __syncthreads();
    }
  }
}
constexpr int NPHASE = 17;

extern "C" void kernel_launch(void* const* d_in, const int* in_sizes, int n_in, void* d_out, int out_size, void* d_ws, size_t ws_size, hipStream_t stream) {
  static int grid_blocks = 0;
  if (!grid_blocks) {
    int dev = 0, cus = 0, per_cu = 0;
    (void)hipGetDevice(&dev);
    (void)hipDeviceGetAttribute(&cus, hipDeviceAttributeMultiprocessorCount, dev);
    (void)hipFuncSetAttribute((const void*)mk_fwd, hipFuncAttributeMaxDynamicSharedMemorySize, LDS_BYTES);
    (void)hipOccupancyMaxActiveBlocksPerMultiprocessor(&per_cu, mk_fwd, 512, LDS_BYTES);
    if (per_cu < 1) { fprintf(stderr, "kernel_launch: occupancy query returned %d\n", per_cu); per_cu = 1; }
    grid_blocks = cus;
  }
  if (ws_size < WS_NEED) { fprintf(stderr, "kernel_launch: workspace too small (%zu < %zu)\n", ws_size, (size_t)WS_NEED); return; }
  Params p{};
  const float** pp = (const float**)&p;
  for (int i = 0; i < 20; ++i) pp[i] = (const float*)d_in[i];
  p.out = (float*)d_out; p.ws = (unsigned char*)d_ws;
#if MULTI_LAUNCH
  for (int ph = 0; ph < NPHASE; ++ph) { p.ph_lo = ph; p.ph_hi = ph + 1; hipLaunchKernelGGL(mk_fwd, dim3(grid_blocks), dim3(512), LDS_BYTES, stream, p); }
#else
  p.ph_lo = 0; p.ph_hi = NPHASE;
  (void)hipMemsetAsync((unsigned char*)d_ws + OFF_BAR, 0, (XCD_BAR_WORDS + 256) * 4, stream);
  void* args[] = {&p};
  hipError_t e = hipLaunchCooperativeKernel((void*)mk_fwd, dim3(grid_blocks), dim3(512), args, LDS_BYTES, stream);
  if (e != hipSuccess) fprintf(stderr, "cooperative launch failed: %s (grid %d)\n", hipGetErrorString(e), grid_blocks);
#endif
}
```

```cpp
#include <hip/hip_runtime.h>
#include <hip/hip_cooperative_groups.h>
#include <cstdio>
namespace cg = cooperative_groups;
#ifndef MULTI_LAUNCH
#define MULTI_LAUNCH 0
#endif
#define LAS __attribute__((address_space(3)))
typedef unsigned short bf16_t;
typedef short bf16x8 __attribute__((ext_vector_type(8)));
typedef float f32x4 __attribute__((ext_vector_type(4)));
typedef unsigned u32x4 __attribute__((ext_vector_type(4)));
typedef unsigned u32x2 __attribute__((ext_vector_type(2)));

constexpr int DM = 2048, NB = 4, SEQ = 4096, CTXL = 256, DFF = 5632, CONVW = 1024, NH = 4, HK = 256, HV = 512;
constexpr int ML = NB * SEQ, MC = NB * CTXL, MT = ML + MC;
constexpr int DIN = 13344, NMODC = 9 * DM;
constexpr int KSPLIT = 8;
constexpr float EPS = 1e-6f;
constexpr size_t MiB = 1048576;
constexpr size_t OFF_W1IN = 0, OFF_W1OUT = 44 * MiB, OFF_WPA = 66 * MiB, OFF_WPB = 83 * MiB, OFF_WCO = 119 * MiB, OFF_WGO = 123 * MiB, OFF_WO = 131 * MiB;
constexpr size_t OFF_U = 139 * MiB, OFF_R = 207 * MiB;
constexpr size_t OFF_ACT = OFF_R, OFF_Y = 394 * MiB, OFF_YC = 530 * MiB;
constexpr size_t OFF_Q = 207 * MiB, OFF_K = 241 * MiB, OFF_VT = 275 * MiB, OFF_QD = 343 * MiB, OFF_KDT = 407 * MiB, OFF_PS = 475 * MiB, OFF_OF = 495 * MiB, OFF_OB = 559 * MiB;
constexpr size_t OFF_PBC = 207 * MiB, OFF_PBR = 303 * MiB, OFF_PBG = 367 * MiB, OFF_T = 495 * MiB, OFF_Z = OFF_PBR, OFF_Y2 = 495 * MiB;
constexpr size_t OFF_ACONV = 66 * MiB, OFF_AGLA = OFF_U;
constexpr size_t OFF_MODP = 640 * MiB, OFF_CX1 = 643 * MiB, OFF_LO = 651 * MiB, OFF_AL = 654 * MiB, OFF_BAR = 657 * MiB, WS_NEED = 658 * MiB;
constexpr int LDS_BYTES = 160 * 1024;

struct Params {
  const float *x, *c, *ctx, *c_ctx, *w_mod, *b_mod, *norm_g, *ffn1_w_in, *ffn1_w_out, *w_in, *conv_w, *conv_b, *conv_out, *gate_up, *gate_bias, *gla_norm_g, *gla_out, *w_o, *ffn2_w_in, *ffn2_w_out;
  float* out; unsigned char* ws; int ph_lo, ph_hi;
};

typedef float f32x2 __attribute__((ext_vector_type(2)));
typedef __bf16 bf16x2_t __attribute__((ext_vector_type(2)));
__device__ __forceinline__ unsigned cvt_pk_bf16(float lo, float hi) { const f32x2 v = {lo, hi}; return __builtin_bit_cast(unsigned, __builtin_convertvector(v, bf16x2_t)); }
__device__ __forceinline__ float bf_lo(unsigned w) { return __uint_as_float(w << 16); }
__device__ __forceinline__ float bf_hi(unsigned w) { return __uint_as_float(w & 0xffff0000u); }
__device__ __forceinline__ float fsigmoid(float v) { return __builtin_amdgcn_rcpf(1.0f + __expf(-v)); }
__device__ __forceinline__ float fsilu(float v) { return v * fsigmoid(v); }
__device__ __forceinline__ float wave_sum(float v) {
#pragma unroll
  for (int o = 32; o >= 1; o >>= 1) v += __shfl_xor(v, o);
  return v;
}

namespace pg8 {
constexpr int BM = 256, BK = 64, HALF = 128, HTB = HALF * BK * 2, STAGE_BYTES = 8 * HTB, NXCD = 8, WGM = 8;
__host__ __device__ __forceinline__ int lds_byte(int r, int c) { const int st = (r >> 4) * 2 + (c >> 5), rr = r & 15, cc = c & 31, ob = rr * 64 + cc * 2; return st * 1024 + (ob ^ (((ob >> 9) & 1) << 5)); }
__host__ __device__ __forceinline__ void stage_rc(int b, int& R, int& C) { const int st = b / 1024, sb = b % 1024, swz = sb ^ (((sb >> 9) & 1) << 5); R = (st >> 1) * 16 + swz / 64; C = (st & 1) * 32 + (swz % 64) / 2; }
__host__ __device__ __forceinline__ int perm32(int rho) { const int n = rho >> 4, i = rho & 15; return 8 * (i >> 2) + 4 * n + (i & 3); }
struct Unit { int pm, pn, ks; };
struct Gemm { const bf16_t* A; const bf16_t* Bt; int M, N, K, ld; };
struct StaticOrder {
  int nM, nN, nwg, G, c, nsplit;
  __device__ void init(int M, int N, int G_, int c_, int nsplit_ = 1) { nM = M / BM; nN = N / BM; nwg = nM * nN; G = G_; c = c_; nsplit = nsplit_; }
  __device__ bool next(int i, Unit& u) const {
    const long L = (long)i * G + c; if (L >= (long)nwg * nsplit) return false;
    u.ks = (int)(L / nwg);
    int wgid = (int)(L % nwg); { const int q = nwg / NXCD, r = nwg % NXCD, xcd = wgid % NXCD, off = wgid / NXCD; wgid = (xcd < r ? xcd * (q + 1) : r * (q + 1) + (xcd - r) * q) + off; }
    const int nig = WGM * nN, gid = wgid / nig, fm = gid * WGM, gsz = (nM - fm) < WGM ? (nM - fm) : WGM;
    u.pm = fm + ((wgid % nig) % gsz); u.pn = (wgid % nig) / gsz; return true;
  }
};

template <class Epi>
__device__ __forceinline__ void gemm_phase(LAS unsigned char* lds, const Gemm g, const StaticOrder& S, const Epi& E) {
  const int tid = threadIdx.x, wid = __builtin_amdgcn_readfirstlane(tid >> 6), lane = tid & 63, wr = wid >> 2, wc = wid & 3, fr = lane & 15, fq = lane >> 4;
  const int K = g.K, nt = K / BK, ld = g.ld;
  unsigned voffA[2], voffB[2];
#pragma unroll
  for (int i = 0; i < 2; ++i) { int R, C; stage_rc(tid * 16 + i * 8192, R, C); const int Rb = Epi::PERM ? ((R & ~31) + perm32(R & 31)) : R;
    voffA[i] = (unsigned)(R * ld + C) * 2u; voffB[i] = (unsigned)(Rb * ld + C) * 2u; }
  const size_t kstep = (size_t)(BK * 2);
  const size_t hstep = (size_t)HALF * ld * 2;
  const size_t sstep = (size_t)K * 2;
  const size_t tstep = 2 * hstep;
  const unsigned ldsw = (unsigned)wid * 1024u;
  const int aoff = lds_byte(wr * 64 + fr, fq * 8), boff = lds_byte(wc * 32 + fr, fq * 8);
#define PG8_SA(b, h) (((b) * 2 + (h)) * HTB)
#define PG8_SB(b, h) ((4 + (b) * 2 + (h)) * HTB)
#define PG8_STAGE(bufoff, gbase, voff) do { _Pragma("unroll") for (int _i = 0; _i < 2; ++_i) \
    __builtin_amdgcn_global_load_lds((const unsigned*)((const char*)(gbase) + (voff)[_i]), (LAS unsigned*)(lds + (bufoff) + ldsw + _i * 8192), 16, 0, 0); } while (0)
#define PG8_LDA(dst, b, h) do { _Pragma("unroll") for (int m = 0; m < 4; ++m) _Pragma("unroll") for (int k = 0; k < 2; ++k) dst[m][k] = *(const LAS bf16x8*)(lds + PG8_SA(b, h) + aoff + m * 2048 + k * 1024); } while (0)
#define PG8_LDB(dst, b, h) do { _Pragma("unroll") for (int n = 0; n < 2; ++n) _Pragma("unroll") for (int k = 0; k < 2; ++k) dst[n][k] = *(const LAS bf16x8*)(lds + PG8_SB(b, h) + boff + n * 2048 + k * 1024); } while (0)
#define PG8_MMA(ai, bj, At, Bt) do { __builtin_amdgcn_s_setprio(1); _Pragma("unroll") for (int m = 0; m < 4; ++m) _Pragma("unroll") for (int n = 0; n < 2; ++n) _Pragma("unroll") for (int k = 0; k < 2; ++k) \
    acc[ai][bj][m][n] = __builtin_amdgcn_mfma_f32_16x16x32_bf16(Bt[n][k], At[m][k], acc[ai][bj][m][n], 0, 0, 0); __builtin_amdgcn_s_setprio(0); } while (0)
#define PG8_WAIT_V(n) asm volatile("s_waitcnt vmcnt(" #n ")" ::: "memory")
#define PG8_WAIT_L(n) asm volatile("s_waitcnt lgkmcnt(" #n ")" ::: "memory")
#define PG8_BAR __builtin_amdgcn_s_barrier()
#define PG8_SCHED __builtin_amdgcn_sched_barrier(0)
  Unit cur, nxt; int ui = 0;
  if (!S.next(0, cur)) return;
  f32x4 acc[2][2][4][2];
#pragma unroll
  for (int a = 0; a < 2; ++a)
#pragma unroll
    for (int b = 0; b < 2; ++b)
#pragma unroll
      for (int m = 0; m < 4; ++m)
#pragma unroll
        for (int n = 0; n < 2; ++n) acc[a][b][m][n] = (f32x4){0.f, 0.f, 0.f, 0.f};
  bf16x8 At[4][2], B0[2][2], B1[2][2];
  const char* cA = (const char*)g.A + (size_t)cur.pm * tstep + (size_t)cur.ks * sstep; const char* cB = (const char*)g.Bt + (size_t)cur.pn * tstep + (size_t)cur.ks * sstep;
  PG8_STAGE(PG8_SB(0, 0), cB, voffB); PG8_STAGE(PG8_SA(0, 0), cA, voffA); PG8_STAGE(PG8_SB(0, 1), cB + hstep, voffB); PG8_STAGE(PG8_SA(0, 1), cA + hstep, voffA);
  if (wr == 1) PG8_BAR;
  PG8_WAIT_V(4); PG8_BAR;
  PG8_STAGE(PG8_SB(1, 0), cB + kstep, voffB); PG8_STAGE(PG8_SA(1, 0), cA + kstep, voffA); PG8_STAGE(PG8_SB(1, 1), cB + hstep + kstep, voffB);
  PG8_WAIT_V(6); PG8_BAR;
  for (;;) {
    const bool has_next = S.next(ui + 1, nxt);
    const char* nA = has_next ? (const char*)g.A + (size_t)nxt.pm * tstep + (size_t)nxt.ks * sstep : cA; const char* nB = has_next ? (const char*)g.Bt + (size_t)nxt.pn * tstep + (size_t)nxt.ks * sstep : cB;
    for (int t = 0; t < nt; t += 2) {
      const bool last = (t == nt - 2);
      const char* a1 = cA + (size_t)(t + 1) * kstep;
      const char* a2 = last ? nA : cA + (size_t)(t + 2) * kstep; const char* b2 = last ? nB : cB + (size_t)(t + 2) * kstep;
      const char* a3 = a2 + kstep; const char* b3 = b2 + kstep;
      PG8_LDB(B0, 0, 0); PG8_SCHED; PG8_LDA(At, 0, 0); PG8_STAGE(PG8_SA(1, 1), a1 + hstep, voffA);
      PG8_WAIT_L(8); PG8_BAR; PG8_WAIT_L(0); PG8_MMA(0, 0, At, B0); PG8_BAR; PG8_SCHED;
      PG8_LDB(B1, 0, 1); PG8_STAGE(PG8_SB(0, 0), b2, voffB);
      PG8_BAR; PG8_WAIT_L(0); PG8_MMA(0, 1, At, B1); PG8_BAR;
      PG8_LDA(At, 0, 1); PG8_STAGE(PG8_SA(0, 0), a2, voffA);
      PG8_BAR; PG8_WAIT_L(0); PG8_MMA(1, 0, At, B0); PG8_BAR; PG8_SCHED;
      PG8_STAGE(PG8_SB(0, 1), b2 + hstep, voffB);
      PG8_WAIT_V(6); PG8_BAR; PG8_MMA(1, 1, At, B1); PG8_BAR;
      PG8_LDB(B0, 1, 0); PG8_SCHED; PG8_LDA(At, 1, 0); PG8_STAGE(PG8_SA(0, 1), a2 + hstep, voffA);
      PG8_WAIT_L(8); PG8_BAR; PG8_WAIT_L(0); PG8_MMA(0, 0, At, B0); PG8_BAR; PG8_SCHED;
      PG8_LDB(B1, 1, 1); PG8_STAGE(PG8_SB(1, 0), b3, voffB);
      PG8_BAR; PG8_WAIT_L(0); PG8_MMA(0, 1, At, B1); PG8_BAR;
      PG8_LDA(At, 1, 1); PG8_STAGE(PG8_SA(1, 0), a3, voffA);
      PG8_BAR; PG8_WAIT_L(0); PG8_MMA(1, 0, At, B0); PG8_BAR; PG8_SCHED;
      PG8_STAGE(PG8_SB(1, 1), b3 + hstep, voffB);
      PG8_WAIT_V(6); PG8_BAR; PG8_MMA(1, 1, At, B1); PG8_BAR;
    }
    E(acc, cur, wr, wc, fr, fq);
    if (!has_next) break;
#pragma unroll
    for (int a = 0; a < 2; ++a)
#pragma unroll
      for (int b = 0; b < 2; ++b)
#pragma unroll
        for (int m = 0; m < 4; ++m)
#pragma unroll
          for (int n = 0; n < 2; ++n) acc[a][b][m][n] = (f32x4){0.f, 0.f, 0.f, 0.f};
    cur = nxt; cA = nA; cB = nB; ++ui;
  }
  PG8_WAIT_V(0);
  if (wr == 0) PG8_BAR;
  PG8_BAR;
#undef PG8_SA
#undef PG8_SB
#undef PG8_STAGE
#undef PG8_LDA
#undef PG8_LDB
#undef PG8_MMA
#undef PG8_WAIT_V
#undef PG8_WAIT_L
#undef PG8_BAR
#undef PG8_SCHED
}
}
using pg8::Unit;
typedef f32x4 AccT[2][2][4][2];

struct EpiSwiglu {
  static constexpr bool PERM = true; bf16_t* O;
  __device__ __forceinline__ void operator()(const AccT& acc, const Unit& u, int wr, int wc, int fr, int fq) const {
    const int row0 = u.pm * 256 + wr * 64 + fr, col0 = u.pn * 128 + wc * 32 + 8 * fq;
#pragma unroll
    for (int ai = 0; ai < 2; ++ai)
#pragma unroll
      for (int m = 0; m < 4; ++m) {
        bf16_t* rowp = O + (size_t)(row0 + ai * 128 + m * 16) * DFF + col0;
        float h[8];
#pragma unroll
        for (int n = 0; n < 2; ++n)
#pragma unroll
          for (int j = 0; j < 4; ++j) { const float a = acc[ai][0][m][n][j], b = acc[ai][1][m][n][j]; h[n * 4 + j] = a * fsilu(b); }
        u32x4 w; w.x = cvt_pk_bf16(h[0], h[1]); w.y = cvt_pk_bf16(h[2], h[3]); w.z = cvt_pk_bf16(h[4], h[5]); w.w = cvt_pk_bf16(h[6], h[7]);
        *(u32x4*)rowp = w;
      }
  }
};
struct EpiF32 {
  static constexpr bool PERM = false; float* C; int ldc;
  __device__ __forceinline__ void operator()(const AccT& acc, const Unit& u, int wr, int wc, int fr, int fq) const {
    const int row0 = u.pm * 256 + wr * 64 + fr, col0 = u.pn * 256 + wc * 32 + 4 * fq;
#pragma unroll
    for (int ai = 0; ai < 2; ++ai)
#pragma unroll
      for (int m = 0; m < 4; ++m) { float* rowp = C + (size_t)(row0 + ai * 128 + m * 16) * ldc + col0;
#pragma unroll
        for (int bj = 0; bj < 2; ++bj)
#pragma unroll
          for (int n = 0; n < 2; ++n) *(f32x4*)(rowp + bj * 128 + n * 16) = acc[ai][bj][m][n]; }
  }
};
struct EpiBf16 {
  static constexpr bool PERM = true; bf16_t* O; int nT;
  __device__ __forceinline__ void operator()(const AccT& acc, const Unit& u, int wr, int wc, int fr, int fq) const {
    bf16_t* base = O + ((size_t)(u.pm * nT + u.pn) << 16) + (wr * 64 + fr) * 256 + wc * 32 + 8 * fq;
#pragma unroll
    for (int ai = 0; ai < 2; ++ai)
#pragma unroll
      for (int m = 0; m < 4; ++m) { bf16_t* rowp = base + (ai * 128 + m * 16) * 256;
#pragma unroll
        for (int bj = 0; bj < 2; ++bj) { const f32x4 v0 = acc[ai][bj][m][0], v1 = acc[ai][bj][m][1];
          u32x4 w; w.x = cvt_pk_bf16(v0[0], v0[1]); w.y = cvt_pk_bf16(v0[2], v0[3]); w.z = cvt_pk_bf16(v1[0], v1[1]); w.w = cvt_pk_bf16(v1[2], v1[3]);
          *(u32x4*)(rowp + bj * 128) = w; } }
  }
};
struct EpiF32Split {
  static constexpr bool PERM = false; float* C; int ldc; size_t slab;
  __device__ __forceinline__ void operator()(const AccT& acc, const Unit& u, int wr, int wc, int fr, int fq) const {
    const int row0 = u.pm * 256 + wr * 64 + fr, col0 = u.pn * 256 + wc * 32 + 4 * fq; float* base = C + (size_t)u.ks * slab;
#pragma unroll
    for (int ai = 0; ai < 2; ++ai)
#pragma unroll
      for (int m = 0; m < 4; ++m) { float* rowp = base + (size_t)(row0 + ai * 128 + m * 16) * ldc + col0;
#pragma unroll
        for (int bj = 0; bj < 2; ++bj)
#pragma unroll
          for (int n = 0; n < 2; ++n) *(f32x4*)(rowp + bj * 128 + n * 16) = acc[ai][bj][m][n]; }
  }
};
struct EpiPA {
  static constexpr bool PERM = true; bf16_t *Q, *K, *VT; float* LO;
  __device__ __forceinline__ void operator()(const AccT& acc, const Unit& u, int wr, int wc, int fr, int fq) const {
    const int row0 = u.pm * 256 + wr * 64 + fr;
    if (u.pn < 8) {
      bf16_t* base = (u.pn < 4 ? Q : K) + ((size_t)(u.pm * 4 + (u.pn & 3)) << 16) + (wr * 64 + fr) * 256 + wc * 32 + 8 * fq;
#pragma unroll
      for (int ai = 0; ai < 2; ++ai)
#pragma unroll
        for (int m = 0; m < 4; ++m) { bf16_t* rowp = base + (ai * 128 + m * 16) * 256;
#pragma unroll
          for (int bj = 0; bj < 2; ++bj) { const f32x4 v0 = acc[ai][bj][m][0], v1 = acc[ai][bj][m][1];
            u32x4 w; w.x = cvt_pk_bf16(v0[0], v0[1]); w.y = cvt_pk_bf16(v0[2], v0[3]); w.z = cvt_pk_bf16(v1[0], v1[1]); w.w = cvt_pk_bf16(v1[2], v1[3]);
            *(u32x4*)(rowp + bj * 128) = w; } }
    } else if (u.pn < 16) {
      const int hv0 = (u.pn - 8) * 256 + wc * 32 + 8 * fq;
#pragma unroll
      for (int ai = 0; ai < 2; ++ai)
#pragma unroll
        for (int m = 0; m < 4; ++m) { const int row = row0 + ai * 128 + m * 16; const int gid = row >> 6, s = row & 63;
          bf16_t* bp = VT + ((size_t)gid * 2048 + hv0) * 64 + s;
#pragma unroll
          for (int bj = 0; bj < 2; ++bj)
#pragma unroll
            for (int n = 0; n < 2; ++n) { const f32x4 v = acc[ai][bj][m][n]; const unsigned w0 = cvt_pk_bf16(v[0], v[1]), w1 = cvt_pk_bf16(v[2], v[3]);
              bf16_t* q = bp + (size_t)(bj * 128 + 4 * n) * 64;
              q[0] = (bf16_t)(w0 & 0xffffu); q[64] = (bf16_t)(w0 >> 16); q[128] = (bf16_t)(w1 & 0xffffu); q[192] = (bf16_t)(w1 >> 16); } }
    } else {
      if (wc == 0) {
#pragma unroll
        for (int ai = 0; ai < 2; ++ai)
#pragma unroll
          for (int m = 0; m < 4; ++m) { float* rowp = LO + (size_t)(row0 + ai * 128 + m * 16) * 32 + 8 * fq;
            *(f32x4*)rowp = acc[ai][0][m][0]; *(f32x4*)(rowp + 4) = acc[ai][0][m][1]; }
      }
    }
  }
};
struct EpiPB {
  static constexpr bool PERM = true; bf16_t *PBc, *PBr, *PBg;
  __device__ __forceinline__ void operator()(const AccT& acc, const Unit& u, int wr, int wc, int fr, int fq) const {
    bf16_t* buf; int nT, pl;
    if (u.pn < 12) { buf = PBc; nT = 12; pl = u.pn; } else if (u.pn < 20) { buf = PBr; nT = 8; pl = u.pn - 12; } else { buf = PBg; nT = 16; pl = u.pn - 20; }
    bf16_t* base = buf + ((size_t)(u.pm * nT + pl) << 16) + (wr * 64 + fr) * 256 + wc * 32 + 8 * fq;
#pragma unroll
    for (int ai = 0; ai < 2; ++ai)
#pragma unroll
      for (int m = 0; m < 4; ++m) { bf16_t* rowp = base + (ai * 128 + m * 16) * 256;
#pragma unroll
        for (int bj = 0; bj < 2; ++bj) { const f32x4 v0 = acc[ai][bj][m][0], v1 = acc[ai][bj][m][1];
          u32x4 w; w.x = cvt_pk_bf16(v0[0], v0[1]); w.y = cvt_pk_bf16(v0[2], v0[3]); w.z = cvt_pk_bf16(v1[0], v1[1]); w.w = cvt_pk_bf16(v1[2], v1[3]);
          *(u32x4*)(rowp + bj * 128) = w; } }
  }
};
struct EpiGateT {
  static constexpr bool PERM = true; const bf16_t* PBg; bf16_t* T;
  __device__ __forceinline__ void operator()(const AccT& acc, const Unit& u, int wr, int wc, int fr, int fq) const {
    const int toff = (wr * 64 + fr) * 256 + wc * 32 + 8 * fq;
    const bf16_t* gb = PBg + ((size_t)(u.pm * 16 + u.pn) << 16) + toff; bf16_t* tb = T + ((size_t)(u.pm * 8 + u.pn) << 16) + toff;
#pragma unroll
    for (int ai = 0; ai < 2; ++ai) {
      u32x4 g[4][2];
#pragma unroll
      for (int m = 0; m < 4; ++m)
#pragma unroll
        for (int bj = 0; bj < 2; ++bj) g[m][bj] = *(const u32x4*)(gb + (ai * 128 + m * 16) * 256 + bj * 128);
#pragma unroll
      for (int m = 0; m < 4; ++m)
#pragma unroll
        for (int bj = 0; bj < 2; ++bj) { const u32x4 gg = g[m][bj]; const f32x4 a0 = acc[ai][bj][m][0], a1 = acc[ai][bj][m][1];
          float z[8];
          z[0] = a0[0] * fsigmoid(bf_lo(gg.x)); z[1] = a0[1] * fsigmoid(bf_hi(gg.x)); z[2] = a0[2] * fsigmoid(bf_lo(gg.y)); z[3] = a0[3] * fsigmoid(bf_hi(gg.y));
          z[4] = a1[0] * fsigmoid(bf_lo(gg.z)); z[5] = a1[1] * fsigmoid(bf_hi(gg.z)); z[6] = a1[2] * fsigmoid(bf_lo(gg.w)); z[7] = a1[3] * fsigmoid(bf_hi(gg.w));
          u32x4 w; w.x = cvt_pk_bf16(z[0], z[1]); w.y = cvt_pk_bf16(z[2], z[3]); w.z = cvt_pk_bf16(z[4], z[5]); w.w = cvt_pk_bf16(z[6], z[7]);
          *(u32x4*)(tb + (ai * 128 + m * 16) * 256 + bj * 128) = w; }
    }
  }
};
struct EpiGateZ {
  static constexpr bool PERM = true; const bf16_t* PBg; const bf16_t* T; bf16_t* Z;
  __device__ __forceinline__ void operator()(const AccT& acc, const Unit& u, int wr, int wc, int fr, int fq) const {
    const int row0 = u.pm * 256 + wr * 64 + fr, col0 = u.pn * 256 + wc * 32 + 8 * fq;
    const int toff = (wr * 64 + fr) * 256 + wc * 32 + 8 * fq;
    const bf16_t* gb = PBg + ((size_t)(u.pm * 16 + 8 + u.pn) << 16) + toff; const bf16_t* tb = T + ((size_t)(u.pm * 8 + u.pn) << 16) + toff;
#pragma unroll
    for (int ai = 0; ai < 2; ++ai) {
      u32x4 g[4][2], tt[4][2];
#pragma unroll
      for (int m = 0; m < 4; ++m)
#pragma unroll
        for (int bj = 0; bj < 2; ++bj) { g[m][bj] = *(const u32x4*)(gb + (ai * 128 + m * 16) * 256 + bj * 128); tt[m][bj] = *(const u32x4*)(tb + (ai * 128 + m * 16) * 256 + bj * 128); }
#pragma unroll
      for (int m = 0; m < 4; ++m) { const size_t row = (size_t)(row0 + ai * 128 + m * 16);
#pragma unroll
        for (int bj = 0; bj < 2; ++bj) { const int col = col0 + bj * 128; const u32x4 gg = g[m][bj], tw = tt[m][bj]; const f32x4 a0 = acc[ai][bj][m][0], a1 = acc[ai][bj][m][1];
          float z[8];
          z[0] = bf_lo(tw.x) + a0[0] * fsigmoid(bf_lo(gg.x)); z[1] = bf_hi(tw.x) + a0[1] * fsigmoid(bf_hi(gg.x)); z[2] = bf_lo(tw.y) + a0[2] * fsigmoid(bf_lo(gg.y)); z[3] = bf_hi(tw.y) + a0[3] * fsigmoid(bf_hi(gg.y));
          z[4] = bf_lo(tw.z) + a1[0] * fsigmoid(bf_lo(gg.z)); z[5] = bf_hi(tw.z) + a1[1] * fsigmoid(bf_hi(gg.z)); z[6] = bf_lo(tw.w) + a1[2] * fsigmoid(bf_lo(gg.w)); z[7] = bf_hi(tw.w) + a1[3] * fsigmoid(bf_hi(gg.w));
          u32x4 w; w.x = cvt_pk_bf16(z[0], z[1]); w.y = cvt_pk_bf16(z[2], z[3]); w.z = cvt_pk_bf16(z[4], z[5]); w.w = cvt_pk_bf16(z[6], z[7]);
          *(u32x4*)(Z + row * 2048 + col) = w; } }
    }
  }
};

template <class Epi>
__device__ __forceinline__ void run_gemm_v(int vb, LAS unsigned char* lds, const bf16_t* A, const bf16_t* Bt, int M, int N, int K, const Epi& E, int nsplit = 1) {
  pg8::Gemm g{A, Bt, M, N, K / nsplit, K}; pg8::StaticOrder S; S.init(M, N, (int)gridDim.x, vb, nsplit);
  pg8::gemm_phase<Epi>(lds, g, S, E);
}

__device__ __forceinline__ void phase_mod(const Params& p, LAS unsigned char* lds) {
  LAS float* sv = (LAS float*)lds;
  LAS float* red = (LAS float*)(lds + 8192);
  float* MODP = (float*)(p.ws + OFF_MODP);
  const int tid = threadIdx.x, wid = tid >> 6, lane = tid & 63;
  for (int item = blockIdx.x; item < 72 * KSPLIT; item += gridDim.x) {
    const int cc = item % 72, ks = item / 72;
    for (int i = tid; i < 5 * 256; i += 512) { const int r = i >> 8, k = ks * 256 + (i & 255); const float v = r < 4 ? p.c[r * DM + k] : p.c_ctx[k]; sv[i] = v / (1.f + __expf(-v)); }
    __syncthreads();
    f32x4 a0 = {0, 0, 0, 0}, a1 = a0, a2 = a0, a3 = a0, a4 = a0;
    const float* wp = p.w_mod + (size_t)(ks * 256 + wid * 32) * NMODC + cc * 256 + lane * 4;
#pragma unroll 8
    for (int k = 0; k < 32; ++k) {
      const f32x4 w = __builtin_nontemporal_load((const f32x4*)(wp + (size_t)k * NMODC));
      const int kk = wid * 32 + k;
      a0 += w * sv[kk]; a1 += w * sv[256 + kk]; a2 += w * sv[512 + kk]; a3 += w * sv[768 + kk]; a4 += w * sv[1024 + kk];
    }
    *(LAS f32x4*)(red + (wid * 5 + 0) * 256 + lane * 4) = a0; *(LAS f32x4*)(red + (wid * 5 + 1) * 256 + lane * 4) = a1; *(LAS f32x4*)(red + (wid * 5 + 2) * 256 + lane * 4) = a2;
    *(LAS f32x4*)(red + (wid * 5 + 3) * 256 + lane * 4) = a3; *(LAS f32x4*)(red + (wid * 5 + 4) * 256 + lane * 4) = a4;
    __syncthreads();
    for (int i = tid; i < 1280; i += 512) { const int r = i >> 8, col = i & 255; float s = 0.f;
#pragma unroll
      for (int w = 0; w < 8; ++w) s += red[(w * 5 + r) * 256 + col];
      if (ks == 0) s += p.b_mod[cc * 256 + col];
      MODP[(size_t)(ks * 5 + r) * NMODC + cc * 256 + col] = s; }
    __syncthreads();
  }
}
__device__ __forceinline__ float modsum(const float* MODP, int r, int idx) { float s = 0.f;
#pragma unroll
  for (int ks = 0; ks < KSPLIT; ++ks) s += MODP[(size_t)(ks * 5 + r) * NMODC + idx];
  return s; }

template <bool NT = false>
__device__ __forceinline__ void conv_tile(const float* src, int ldsrc, int sc0, bf16_t* dst, int K, int nd0, int k0, LAS unsigned char* lds) {
  LAS unsigned* T = (LAS unsigned*)lds;
  const int tid = threadIdx.x, nq = tid & 15, kp = tid >> 4;
#pragma unroll
  for (int pass = 0; pass < 2; ++pass) {
    const int kk = (pass * 32 + kp) * 2;
    const float* s0 = src + (size_t)(k0 + kk) * ldsrc + sc0 + nq * 4;
    const f32x4 a = __builtin_nontemporal_load((const f32x4*)s0), b = __builtin_nontemporal_load((const f32x4*)(s0 + ldsrc));
#pragma unroll
    for (int j = 0; j < 4; ++j) T[(nq * 4 + j) * 65 + pass * 32 + kp] = cvt_pk_bf16(a[j], b[j]);
  }
  __syncthreads();
  { const int row = tid >> 3, seg = tid & 7; u32x4 w0, w1;
    w0.x = T[row * 65 + seg * 8 + 0]; w0.y = T[row * 65 + seg * 8 + 1]; w0.z = T[row * 65 + seg * 8 + 2]; w0.w = T[row * 65 + seg * 8 + 3];
    w1.x = T[row * 65 + seg * 8 + 4]; w1.y = T[row * 65 + seg * 8 + 5]; w1.z = T[row * 65 + seg * 8 + 6]; w1.w = T[row * 65 + seg * 8 + 7];
    bf16_t* d = dst + (size_t)(nd0 + row) * K + k0 + seg * 16;
    if (NT) { __builtin_nontemporal_store(w0, (u32x4*)d); __builtin_nontemporal_store(w1, (u32x4*)(d + 8)); } else { *(u32x4*)d = w0; *(u32x4*)(d + 8) = w1; } }
  __syncthreads();
}
__device__ __forceinline__ void conv_job(const float* src, int ldsrc, bf16_t* dst, int K, int ngroups, int map, int& tbase, LAS unsigned char* lds) {
  const int nk = K >> 7, nt = ngroups * nk, G = (int)gridDim.x;
  int t = ((int)blockIdx.x - (tbase % G) + G) % G;
  for (; t < nt; t += G) {
    const int ng = t / nk, kt = t - ng * nk, nd0 = ng * 64; int sc0;
    if (map == 0) sc0 = nd0;
    else if (map == 1) sc0 = ((nd0 & 255) >> 7) * DFF + (nd0 >> 8) * 128 + (nd0 & 127);
    else if (map == 2) sc0 = nd0 < 4096 ? 3072 + nd0 : 9216 + (nd0 - 4096);
    else sc0 = nd0 < 3072 ? nd0 : (nd0 < 5120 ? 7168 + (nd0 - 3072) : 9248 + (nd0 - 5120));
    conv_tile(src, ldsrc, sc0, dst, K, nd0, kt * 128, lds);
  }
  tbase += nt;
}

__device__ __forceinline__ void conv_queue(const Params& p, int q, LAS unsigned char* lds) {
  LAS unsigned* slot = (LAS unsigned*)(lds + 20480);
  unsigned* counter = (unsigned*)(p.ws + OFF_BAR) + 3456 + 64 + 64 * q;
  const int total = q == 0 ? 3584 : 4224;
  for (;;) {
    if (threadIdx.x == 0) slot[0] = __hip_atomic_fetch_add(counter, 1u, __ATOMIC_RELAXED, __HIP_MEMORY_SCOPE_AGENT);
    __syncthreads();
    int t = (int)slot[0];
    __syncthreads();
    if (t >= total) break;
    const float* src; bf16_t* dst; int ldsrc, K, map;
    if (q == 0) {
      if (t < 2304) { src = p.w_in; dst = (bf16_t*)(p.ws + OFF_WPB); ldsrc = DIN; K = DM; map = 3; }
      else if (t < 2560) { t -= 2304; src = p.conv_out; dst = (bf16_t*)(p.ws + OFF_WCO); ldsrc = DM; K = CONVW; map = 0; }
      else if (t < 3072) { t -= 2560; src = p.gla_out; dst = (bf16_t*)(p.ws + OFF_WGO); ldsrc = DM; K = DM; map = 0; }
      else { t -= 3072; src = p.w_o; dst = (bf16_t*)(p.ws + OFF_WO); ldsrc = DM; K = DM; map = 0; }
    } else {
      if (t < 2816) { src = p.ffn2_w_in; dst = (bf16_t*)(p.ws + OFF_W1IN); ldsrc = 2 * DFF; K = DM; map = 1; }
      else { t -= 2816; src = p.ffn2_w_out; dst = (bf16_t*)(p.ws + OFF_W1OUT); ldsrc = DM; K = DFF; map = 0; }
    }
    const int nk = K >> 7, ng = t / nk, kt = t - ng * nk, nd0 = ng * 64; int sc0;
    if (map == 0) sc0 = nd0;
    else if (map == 1) sc0 = ((nd0 & 255) >> 7) * DFF + (nd0 >> 8) * 128 + (nd0 & 127);
    else sc0 = nd0 < 3072 ? nd0 : (nd0 < 5120 ? 7168 + (nd0 - 3072) : 9248 + (nd0 - 5120));
    conv_tile<true>(src, ldsrc, sc0, dst, K, nd0, kt * 128, lds);
  }
}

__device__ __forceinline__ void rows_norm_mod(const float* xsrc, bf16_t* udst, int nrows, const LAS float* Av, const LAS float* Bv) {
  const int wid = threadIdx.x >> 6, lane = threadIdx.x & 63;
  for (int row = blockIdx.x * 8 + wid; row < nrows; row += gridDim.x * 8) {
    const float* xr = xsrc + (size_t)row * DM; f32x4 v[8]; float ss = 0.f;
#pragma unroll
    for (int i = 0; i < 8; ++i) { v[i] = __builtin_nontemporal_load((const f32x4*)(xr + (i * 64 + lane) * 4)); ss += v[i][0] * v[i][0] + v[i][1] * v[i][1] + v[i][2] * v[i][2] + v[i][3] * v[i][3]; }
    ss = wave_sum(ss); const float rs = rsqrtf(ss * (1.0f / DM) + EPS);
    bf16_t* ur = udst + (size_t)row * DM;
#pragma unroll
    for (int i = 0; i < 8; ++i) { const int c = (i * 64 + lane) * 4; const f32x4 a = *(const LAS f32x4*)(Av + c), b = *(const LAS f32x4*)(Bv + c); const f32x4 o = v[i] * rs * a + b;
      u32x2 w; w.x = cvt_pk_bf16(o[0], o[1]); w.y = cvt_pk_bf16(o[2], o[3]); *(u32x2*)(ur + c) = w; }
  }
}
template <bool HAS_U, bool YSPLIT = false>
__device__ __forceinline__ void rows_resid(const float* xsrc, const bf16_t* y, float* xdst, bf16_t* udst, int nrows, const LAS float* Gv, const LAS float* Av, const LAS float* Bv) {
  const int wid = threadIdx.x >> 6, lane = threadIdx.x & 63;
  for (int row = blockIdx.x * 8 + wid; row < nrows; row += gridDim.x * 8) {
    const bf16_t* yr = y + (size_t)row * DM; const float* xr = xsrc + (size_t)row * DM; f32x4 v[8]; float ss = 0.f;
#pragma unroll
    for (int i = 0; i < 8; ++i) {
      if (YSPLIT) { const float* yf = (const float*)y + (size_t)row * DM + (i * 64 + lane) * 4; v[i] = *(const f32x4*)yf + *(const f32x4*)(yf + (size_t)MC * DM) + *(const f32x4*)(yf + 2 * (size_t)MC * DM) + *(const f32x4*)(yf + 3 * (size_t)MC * DM); }
      else { const u32x2 yw = __builtin_nontemporal_load((const u32x2*)(y + ((size_t)((row >> 8) * 8 + i) << 16) + (row & 255) * 256 + lane * 4)); v[i] = (f32x4){bf_lo(yw.x), bf_hi(yw.x), bf_lo(yw.y), bf_hi(yw.y)}; } ss += v[i][0] * v[i][0] + v[i][1] * v[i][1] + v[i][2] * v[i][2] + v[i][3] * v[i][3]; }
    ss = wave_sum(ss); const float rs = rsqrtf(ss * (1.0f / DM) + EPS);
    float s2 = 0.f; float* xo = xdst + (size_t)row * DM;
#pragma unroll
    for (int i = 0; i < 8; ++i) { const int c = (i * 64 + lane) * 4; const f32x4 g = *(const LAS f32x4*)(Gv + c); const f32x4 xv = __builtin_nontemporal_load((const f32x4*)(xr + c));
      v[i] = xv + v[i] * rs * g; __builtin_nontemporal_store(v[i], (f32x4*)(xo + c)); s2 += v[i][0] * v[i][0] + v[i][1] * v[i][1] + v[i][2] * v[i][2] + v[i][3] * v[i][3]; }
    if (HAS_U) {
      s2 = wave_sum(s2); const float r2 = rsqrtf(s2 * (1.0f / DM) + EPS); bf16_t* ur = udst + (size_t)row * DM;
#pragma unroll
      for (int i = 0; i < 8; ++i) { const int c = (i * 64 + lane) * 4; const f32x4 a = *(const LAS f32x4*)(Av + c), b = *(const LAS f32x4*)(Bv + c); const f32x4 o = v[i] * r2 * a + b;
        u32x2 w; w.x = cvt_pk_bf16(o[0], o[1]); w.y = cvt_pk_bf16(o[2], o[3]); *(u32x2*)(ur + c) = w; }
    }
  }
}
__device__ __forceinline__ void fill_vecs(const Params& p, int r, int mg, float gscale, int ng_post, int ng_pre, int msc, int msh, LAS float* Gv, LAS float* Av, LAS float* Bv) {
  const float* MODP = (const float*)(p.ws + OFF_MODP);
  for (int c = threadIdx.x; c < DM; c += 512) {
    if (mg >= 0) Gv[c] = gscale * modsum(MODP, r, mg * DM + c) * p.norm_g[ng_post * DM + c];
    if (ng_pre >= 0) { Av[c] = p.norm_g[ng_pre * DM + c] * (1.0f + modsum(MODP, r, msc * DM + c)); Bv[c] = modsum(MODP, r, msh * DM + c); }
  }
}

__device__ __forceinline__ void unpack8(const u32x4 w, float (&f)[8]) { f[0] = bf_lo(w.x); f[1] = bf_hi(w.x); f[2] = bf_lo(w.y); f[3] = bf_hi(w.y); f[4] = bf_lo(w.z); f[5] = bf_hi(w.z); f[6] = bf_lo(w.w); f[7] = bf_hi(w.w); }
__device__ __forceinline__ void phase_prep(const Params& p, LAS unsigned char* lds) {
  constexpr int BCS = 260;
  LAS float* Bc = (LAS float*)lds;
  LAS float* lol = (LAS float*)(lds + 66560);
  LAS float* Tt = (LAS float*)(lds + 70656);
  LAS float* Hs = (LAS float*)(lds + 71680);
  LAS unsigned char* Ql = lds + 73728;
  LAS unsigned char* Kd = lds + 73728 + 33792;
  const bf16_t* Q = (const bf16_t*)(p.ws + OFF_Q); const bf16_t* Kg = (const bf16_t*)(p.ws + OFF_K); const float* LO = (const float*)(p.ws + OFF_LO);
  bf16_t* QD = (bf16_t*)(p.ws + OFF_QD); bf16_t* KDT = (bf16_t*)(p.ws + OFF_KDT); bf16_t* PS = (bf16_t*)(p.ws + OFF_PS); float* AL = (float*)(p.ws + OFF_AL);
  const int tid = threadIdx.x, wid = tid >> 6, lane = tid & 63, fr = lane & 15, fq = lane >> 4;
  for (int wi = blockIdx.x; wi < 272 * 8; wi += gridDim.x) {
    const int item = wi >> 1, dir = wi & 1, gid = item >> 2, h = item & 3, row0 = gid * 64; const bool is_ctx = gid >= 256;
    const size_t itd = (size_t)wi;
    u32x4 rq[4], rk[4];
#pragma unroll
    for (int j = 0; j < 4; ++j) { const int v = tid + 512 * j, i = v >> 5, k8 = (v & 31) * 8;
      const size_t qoff = ((size_t)((gid >> 2) * 4 + h) << 16) + (size_t)((gid & 3) * 64 + i) * 256 + k8;
      rk[j] = *(const u32x4*)(Kg + qoff);
      rq[j] = is_ctx ? (u32x4){0, 0, 0, 0} : *(const u32x4*)(Q + qoff); }
    if (tid < 256) { const int i = tid >> 2, j4 = (tid & 3) * 4; *(LAS f32x4*)(lol + i * 16 + j4) = *(const f32x4*)(LO + (size_t)(row0 + i) * 32 + dir * 16 + j4); }
    __syncthreads();
    {
      const int half = tid >> 8, col = tid & 255, kk = h * 256 + col; float up[16];
#pragma unroll
      for (int r = 0; r < 16; ++r) up[r] = p.gate_up[(size_t)(dir * 16 + r) * 1024 + kk];
      const float bias = p.gate_bias[dir * 1024 + kk]; float la[32]; float tot = 0.f;
#pragma unroll
      for (int ii = 0; ii < 32; ++ii) { const int i = half * 32 + ii; float z = bias;
#pragma unroll
        for (int r4 = 0; r4 < 4; ++r4) { const f32x4 l = *(const LAS f32x4*)(lol + i * 16 + r4 * 4); z += l[0] * up[r4 * 4] + l[1] * up[r4 * 4 + 1] + l[2] * up[r4 * 4 + 2] + l[3] * up[r4 * 4 + 3]; }
        la[ii] = (fminf(z, 0.f) - __logf(1.0f + __expf(-fabsf(z)))) * (1.0f / 16.0f); tot += la[ii]; }
      Hs[half * 256 + col] = tot;
      __syncthreads();
      float run = half ? Hs[col] : 0.f;
#pragma unroll
      for (int ii = 0; ii < 32; ++ii) { const int i = half * 32 + ii; if (dir == 0) { run += la[ii]; Bc[i * BCS + col] = run; } else { Bc[i * BCS + col] = run; run += la[ii]; } }
      if (half) { Tt[col] = run; AL[itd * 256 + col] = __expf(run); }
    }
    __syncthreads();
#pragma unroll
    for (int j = 0; j < 4; ++j) { const int v = tid + 512 * j, i = v >> 5, k8 = (v & 31) * 8; float q[8], kv[8]; unpack8(rq[j], q); unpack8(rk[j], kv);
      const f32x4 x0 = *(const LAS f32x4*)(Bc + i * BCS + k8), x1 = *(const LAS f32x4*)(Bc + i * BCS + k8 + 4), t0 = *(const LAS f32x4*)(Tt + k8), t1 = *(const LAS f32x4*)(Tt + k8 + 4);
      float oq[8], ok[8], op[8];
#pragma unroll
      for (int e = 0; e < 8; ++e) { const float x = e < 4 ? x0[e & 3] : x1[e & 3], T = e < 4 ? t0[e & 3] : t1[e & 3];
        const float eq = __expf(dir == 0 ? x : T - x), ek = __expf(dir == 0 ? T - x : x); const float qs = q[e] * 0.0625f;
        oq[e] = qs * eq; ok[e] = kv[e] * ek; op[e] = qs * __builtin_amdgcn_rcpf(ek); }
      u32x4 w;
      if (!is_ctx) { w.x = cvt_pk_bf16(oq[0], oq[1]); w.y = cvt_pk_bf16(oq[2], oq[3]); w.z = cvt_pk_bf16(oq[4], oq[5]); w.w = cvt_pk_bf16(oq[6], oq[7]);
        *(u32x4*)(QD + itd * 16384 + i * 256 + k8) = w;
        w.x = cvt_pk_bf16(op[0], op[1]); w.y = cvt_pk_bf16(op[2], op[3]); w.z = cvt_pk_bf16(op[4], op[5]); w.w = cvt_pk_bf16(op[6], op[7]);
        *(LAS u32x4*)(Ql + i * 528 + k8 * 2) = w; }
      w.x = cvt_pk_bf16(ok[0], ok[1]); w.y = cvt_pk_bf16(ok[2], ok[3]); w.z = cvt_pk_bf16(ok[4], ok[5]); w.w = cvt_pk_bf16(ok[6], ok[7]);
      *(LAS u32x4*)(Kd + i * 528 + k8 * 2) = w; }
    __syncthreads();
#pragma unroll
    for (int j = 0; j < 4; ++j) { const int v = tid + 512 * j, k = v >> 3, s8 = (v & 7) * 8; unsigned short o[8];
#pragma unroll
      for (int e = 0; e < 8; ++e) o[e] = *(const LAS unsigned short*)(Kd + (s8 + e) * 528 + k * 2);
      u32x4 w; w.x = (unsigned)o[0] | ((unsigned)o[1] << 16); w.y = (unsigned)o[2] | ((unsigned)o[3] << 16); w.z = (unsigned)o[4] | ((unsigned)o[5] << 16); w.w = (unsigned)o[6] | ((unsigned)o[7] << 16);
      *(u32x4*)(KDT + itd * 16384 + k * 64 + s8) = w; }
    if (!is_ctx) {
      const int cb = wid >> 1, sb0 = (wid & 1) * 2; f32x4 acc[2] = {{0, 0, 0, 0}, {0, 0, 0, 0}};
#pragma unroll
      for (int ks = 0; ks < 8; ++ks) { const bf16x8 qf = *(const LAS bf16x8*)(Ql + (cb * 16 + fr) * 528 + (ks * 32 + fq * 8) * 2);
#pragma unroll
        for (int t = 0; t < 2; ++t) { const bf16x8 kf = *(const LAS bf16x8*)(Kd + ((sb0 + t) * 16 + fr) * 528 + (ks * 32 + fq * 8) * 2); acc[t] = __builtin_amdgcn_mfma_f32_16x16x32_bf16(kf, qf, acc[t], 0, 0, 0); } }
      const int c = cb * 16 + fr;
#pragma unroll
      for (int t = 0; t < 2; ++t) { const int s0 = (sb0 + t) * 16 + fq * 4; float o[4];
#pragma unroll
        for (int r = 0; r < 4; ++r) { const int s = s0 + r; const bool keep = dir == 0 ? (s <= c) : (s >= c); o[r] = keep ? acc[t][r] : 0.f; }
        u32x2 w; w.x = cvt_pk_bf16(o[0], o[1]); w.y = cvt_pk_bf16(o[2], o[3]); *(u32x2*)(PS + itd * 4096 + c * 64 + s0) = w; }
    }
    __syncthreads();
  }
}

__device__ __forceinline__ void phase_chain(const Params& p, LAS unsigned char* lds, int vb) {
  constexpr int KDT_O = 0, VT_O = 36864, PS_O = VT_O + 9216, QD_O = PS_O + 9216, SB_O = QD_O + 33792, AL_O = SB_O + 33792;
  const bf16_t* QD = (const bf16_t*)(p.ws + OFF_QD); const bf16_t* KDT = (const bf16_t*)(p.ws + OFF_KDT); const bf16_t* PS = (const bf16_t*)(p.ws + OFF_PS);
  const bf16_t* VT = (const bf16_t*)(p.ws + OFF_VT); const float* AL = (const float*)(p.ws + OFF_AL);
  const int tid = threadIdx.x, wid = __builtin_amdgcn_readfirstlane(tid >> 6), lane = tid & 63, fr = lane & 15, fq = lane >> 4;
  for (int cid = vb; cid < 256; cid += gridDim.x) {
    const int xcd = cid & 7, w = cid >> 3, vs = w & 7, bhd = xcd * 4 + (w >> 3), b = bhd >> 3, h = (bhd >> 1) & 3, dir = bhd & 1;
    bf16_t* O = (bf16_t*)(p.ws + (dir ? OFF_OB : OFF_OF));
    f32x4 S[2][4];
#pragma unroll
    for (int a = 0; a < 2; ++a)
#pragma unroll
      for (int v = 0; v < 4; ++v) S[a][v] = (f32x4){0.f, 0.f, 0.f, 0.f};
    u32x4 rk[4], rq[4], rv, rp; float ra = 0.f;
#pragma unroll
    for (int j = 0; j < 4; ++j) rq[j] = (u32x4){0, 0, 0, 0};
    rp = (u32x4){0, 0, 0, 0};
#define CH_GID(st) ((st) < 4 ? 256 + b * 4 + (dir ? 3 - (st) : (st)) : b * 64 + (dir ? 67 - (st) : (st) - 4))
#define CH_LOAD(st) do { const int gid_ = CH_GID(st); const size_t it_ = ((size_t)gid_ * 4 + h) * 2 + dir; \
      _Pragma("unroll") for (int j = 0; j < 4; ++j) rk[j] = *(const u32x4*)(KDT + it_ * 16384 + (size_t)(tid + 512 * j) * 8); \
      rv = *(const u32x4*)(VT + ((size_t)gid_ * 2048 + h * 512 + vs * 64) * 64 + (size_t)tid * 8); \
      if ((st) >= 4) { _Pragma("unroll") for (int j = 0; j < 4; ++j) rq[j] = *(const u32x4*)(QD + it_ * 16384 + (size_t)(tid + 512 * j) * 8); rp = *(const u32x4*)(PS + it_ * 4096 + (size_t)tid * 8); } \
      if (tid < 256) ra = AL[it_ * 256 + tid]; } while (0)
    CH_LOAD(0);
    for (int st = 0; st < 68; ++st) {
      const bool latent = st >= 4;
#pragma unroll
      for (int j = 0; j < 4; ++j) { const int v = tid + 512 * j; *(LAS u32x4*)(lds + KDT_O + (v >> 3) * 144 + (v & 7) * 16) = rk[j]; }
      *(LAS u32x4*)(lds + VT_O + (tid >> 3) * 144 + (tid & 7) * 16) = rv;
      if (latent) {
#pragma unroll
        for (int j = 0; j < 4; ++j) { const int v = tid + 512 * j; *(LAS u32x4*)(lds + QD_O + (v >> 5) * 528 + (v & 31) * 16) = rq[j]; }
        *(LAS u32x4*)(lds + PS_O + (tid >> 3) * 144 + (tid & 7) * 16) = rp;
#pragma unroll
        for (int a = 0; a < 2; ++a)
#pragma unroll
          for (int vb = 0; vb < 4; ++vb) { u32x2 wv; wv.x = cvt_pk_bf16(S[a][vb][0], S[a][vb][1]); wv.y = cvt_pk_bf16(S[a][vb][2], S[a][vb][3]);
            *(LAS u32x2*)(lds + SB_O + (vb * 16 + fr) * 528 + ((2 * wid + a) * 16 + fq * 4) * 2) = wv; }
      }
      if (tid < 256) *(LAS float*)(lds + AL_O + tid * 4) = ra;
      __syncthreads();
      const int gid = CH_GID(st);
      if (st + 1 < 68) CH_LOAD(st + 1);
      if (latent) {
        const int cb = wid >> 1, vb0 = (wid & 1) * 2; f32x4 o[2] = {{0, 0, 0, 0}, {0, 0, 0, 0}};
#pragma unroll
        for (int ks = 0; ks < 2; ++ks) { const bf16x8 pf = *(const LAS bf16x8*)(lds + PS_O + (cb * 16 + fr) * 144 + (ks * 32 + fq * 8) * 2);
#pragma unroll
          for (int t = 0; t < 2; ++t) { const bf16x8 vf = *(const LAS bf16x8*)(lds + VT_O + ((vb0 + t) * 16 + fr) * 144 + (ks * 32 + fq * 8) * 2); o[t] = __builtin_amdgcn_mfma_f32_16x16x32_bf16(vf, pf, o[t], 0, 0, 0); } }
#pragma unroll
        for (int ks = 0; ks < 8; ++ks) { const bf16x8 qf = *(const LAS bf16x8*)(lds + QD_O + (cb * 16 + fr) * 528 + (ks * 32 + fq * 8) * 2);
#pragma unroll
          for (int t = 0; t < 2; ++t) { const bf16x8 sf = *(const LAS bf16x8*)(lds + SB_O + ((vb0 + t) * 16 + fr) * 528 + (ks * 32 + fq * 8) * 2); o[t] = __builtin_amdgcn_mfma_f32_16x16x32_bf16(sf, qf, o[t], 0, 0, 0); } }
        const size_t row = (size_t)gid * 64 + cb * 16 + fr;
#pragma unroll
        for (int t = 0; t < 2; ++t) { u32x2 wv; wv.x = cvt_pk_bf16(o[t][0], o[t][1]); wv.y = cvt_pk_bf16(o[t][2], o[t][3]); __builtin_nontemporal_store(wv, (u32x2*)(O + row * 2048 + h * 512 + vs * 64 + (vb0 + t) * 16 + fq * 4)); }
      }
#pragma unroll
      for (int a = 0; a < 2; ++a) {
        const f32x4 al = *(const LAS f32x4*)(lds + AL_O + ((2 * wid + a) * 16 + fq * 4) * 4);
        bf16x8 kf[2];
#pragma unroll
        for (int ks = 0; ks < 2; ++ks) kf[ks] = *(const LAS bf16x8*)(lds + KDT_O + ((2 * wid + a) * 16 + fr) * 144 + (ks * 32 + fq * 8) * 2);
#pragma unroll
        for (int vb = 0; vb < 4; ++vb) { S[a][vb] *= al;
#pragma unroll
          for (int ks = 0; ks < 2; ++ks) { const bf16x8 vf = *(const LAS bf16x8*)(lds + VT_O + (vb * 16 + fr) * 144 + (ks * 32 + fq * 8) * 2); S[a][vb] = __builtin_amdgcn_mfma_f32_16x16x32_bf16(kf[ks], vf, S[a][vb], 0, 0, 0); } }
      }
      __syncthreads();
    }
#undef CH_LOAD
#undef CH_GID
  }
}

__device__ __forceinline__ void phase_mix_elem(const Params& p) {
  const bf16_t* PBc = (const bf16_t*)(p.ws + OFF_PBC); const bf16_t* PBr = (const bf16_t*)(p.ws + OFF_PBR);
  const bf16_t* OF = (const bf16_t*)(p.ws + OFF_OF); const bf16_t* OB = (const bf16_t*)(p.ws + OFF_OB);
  bf16_t* AC = (bf16_t*)(p.ws + OFF_ACONV); bf16_t* AG = (bf16_t*)(p.ws + OFF_AGLA);
  const int wid = threadIdx.x >> 6, lane = threadIdx.x & 63;
  for (int row = blockIdx.x * 8 + wid; row < ML; row += gridDim.x * 8) {
    const int gc = row & 63; const bool hasl = gc != 0, hasr = gc != 63;
#pragma unroll
    for (int half = 0; half < 2; ++half) {
      const int c = half * 512 + lane * 8; float zc[8], zl[8], zr[8], t0[8], t1[8], bg[8];
      const bf16_t* pr = PBc + ((size_t)((row >> 8) * 12 + (c >> 8)) << 16) + (row & 255) * 256 + (c & 255);
      constexpr int TC = 4 << 16, TH = 8 << 16;
      unpack8(*(const u32x4*)(pr + TC), t0); unpack8(*(const u32x4*)(pr + TH), t1);
#pragma unroll
      for (int e = 0; e < 8; ++e) zc[e] = t0[e] * t1[e];
      if (hasl) { unpack8(*(const u32x4*)(pr - 256 + TC), t0); unpack8(*(const u32x4*)(pr - 256 + TH), t1);
#pragma unroll
        for (int e = 0; e < 8; ++e) zl[e] = t0[e] * t1[e]; } else {
#pragma unroll
        for (int e = 0; e < 8; ++e) zl[e] = 0.f; }
      if (hasr) { unpack8(*(const u32x4*)(pr + 256 + TC), t0); unpack8(*(const u32x4*)(pr + 256 + TH), t1);
#pragma unroll
        for (int e = 0; e < 8; ++e) zr[e] = t0[e] * t1[e]; } else {
#pragma unroll
        for (int e = 0; e < 8; ++e) zr[e] = 0.f; }
      unpack8(*(const u32x4*)pr, bg);
      float o[8];
#pragma unroll
      for (int e = 0; e < 8; ++e) o[e] = bg[e] * (p.conv_w[c + e] * zl[e] + p.conv_w[1024 + c + e] * zc[e] + p.conv_w[2048 + c + e] * zr[e] + p.conv_b[c + e]);
      u32x4 w; w.x = cvt_pk_bf16(o[0], o[1]); w.y = cvt_pk_bf16(o[2], o[3]); w.z = cvt_pk_bf16(o[4], o[5]); w.w = cvt_pk_bf16(o[6], o[7]);
      *(u32x4*)(AC + (size_t)row * 1024 + c) = w;
    }
#pragma unroll
    for (int h = 0; h < 4; ++h) {
      const int c = h * 512 + lane * 8; float a[8], b[8], r[8], o[8]; float ss = 0.f;
      unpack8(__builtin_nontemporal_load((const u32x4*)(OF + (size_t)row * 2048 + c)), a); unpack8(__builtin_nontemporal_load((const u32x4*)(OB + (size_t)row * 2048 + c)), b); unpack8(*(const u32x4*)(PBr + ((size_t)((row >> 8) * 8 + (c >> 8)) << 16) + (row & 255) * 256 + (c & 255)), r);
#pragma unroll
      for (int e = 0; e < 8; ++e) { a[e] += b[e]; ss += a[e] * a[e]; }
      ss = wave_sum(ss); const float rs = rsqrtf(ss * (1.0f / HV) + EPS);
#pragma unroll
      for (int e = 0; e < 8; ++e) o[e] = a[e] * rs * p.gla_norm_g[c + e] * fsilu(r[e]);
      u32x4 w; w.x = cvt_pk_bf16(o[0], o[1]); w.y = cvt_pk_bf16(o[2], o[3]); w.z = cvt_pk_bf16(o[4], o[5]); w.w = cvt_pk_bf16(o[6], o[7]);
      *(u32x4*)(AG + (size_t)row * 2048 + c) = w;
    }
  }
}


#define XB_TMO      128
#define XB_XCNT(j)  (256  + 64 * (j))
#define XB_XSUB(j)  (1280 + 64 * (j))
#define XB_XGEN(j)  (2304 + 64 * (j))
#define XB_TOP      3328
#define XB_TOPGEN   3392
#define XCD_BAR_WORDS 3456
#define XB_SPIN_CAP (1u << 18)
__device__ __forceinline__ unsigned xb_ld(unsigned* p)              { return __hip_atomic_load(p, __ATOMIC_RELAXED, __HIP_MEMORY_SCOPE_AGENT); }
__device__ __forceinline__ unsigned xb_add(unsigned* p, unsigned v) { return __hip_atomic_fetch_add(p, v, __ATOMIC_RELAXED, __HIP_MEMORY_SCOPE_AGENT); }
__device__ __forceinline__ unsigned xb_xcc_id() { return (unsigned)__builtin_amdgcn_s_getreg((3 << 11) | 20) & 0xFu; }
#define XB_SPIN(cond, bar) do { unsigned _sp = 0; while (cond) { __builtin_amdgcn_s_sleep(1); \
    if ((++_sp & 255u) == 0u) { if (xb_ld(&(bar)[XB_TMO])) break; if (_sp > XB_SPIN_CAP) { atomicAdd(&(bar)[XB_TMO], 1u); break; } } } } while (0)
struct XcdBarrier { unsigned* bar; unsigned x; volatile LAS unsigned* st; };
__device__ __forceinline__ XcdBarrier xcd_barrier_post(unsigned* bar, volatile LAS unsigned* st) {
    XcdBarrier b; b.bar = bar; b.x = xb_xcc_id(); b.st = st;
    if (threadIdx.x == 0) st[2] = xb_add(&bar[XB_XCNT(b.x)], 1u);
    return b;
}
__device__ __forceinline__ void xcd_barrier_complete(unsigned* bar, unsigned x, unsigned& nloc, unsigned& nx) {
    const unsigned G = gridDim.x * gridDim.y * gridDim.z;
    unsigned sum, cnt, mine, sp = 0u;
    for (;;) {
        sum = 0u; cnt = 0u; mine = 0u;
#pragma unroll
        for (unsigned j = 0; j < 16; ++j) { const unsigned c = xb_ld(&bar[XB_XCNT(j)]); sum += c; cnt += (c > 0u) ? 1u : 0u; mine = (j == x) ? c : mine; }
        if (sum == G) break;
        __builtin_amdgcn_s_sleep(1);
        if ((++sp & 255u) == 0u) { if (xb_ld(&bar[XB_TMO])) break; if (sp > XB_SPIN_CAP) { atomicAdd(&bar[XB_TMO], 1u); break; } }
    }
    nloc = mine > 0u ? mine : 1u; nx = cnt > 0u ? cnt : 1u;
}
__device__ __forceinline__ void xcd_barrier(const XcdBarrier& b) {
    asm volatile("s_waitcnt vmcnt(0)" ::: "memory");
    __syncthreads();
    if (threadIdx.x == 0) {
        unsigned* bar = b.bar;
        __builtin_amdgcn_s_waitcnt(0);
        unsigned nloc = b.st[0], nx = b.st[1];
        if (nloc == 0u) { xcd_barrier_complete(bar, b.x, nloc, nx); b.st[0] = nloc; b.st[1] = nx; }
        const unsigned old = xb_add(&bar[XB_XSUB(b.x)], 1u);
        const unsigned gen = old / nloc;
        if (old + 1u == (gen + 1u) * nloc) {
            __builtin_amdgcn_fence(__ATOMIC_RELEASE, "agent");
            asm volatile("s_waitcnt vmcnt(0)" ::: "memory");
            const unsigned og = xb_add(&bar[XB_TOP], 1u);
            const unsigned tg = og / nx;
            if (og + 1u == (tg + 1u) * nx) xb_add(&bar[XB_TOPGEN], 1u);
            else XB_SPIN(xb_ld(&bar[XB_TOPGEN]) == tg, bar);
            __builtin_amdgcn_fence(__ATOMIC_ACQUIRE, "agent");
            xb_add(&bar[XB_XGEN(b.x)], 1u);
            asm volatile("s_waitcnt vmcnt(0)" ::: "memory");
        } else {
            XB_SPIN(xb_ld(&bar[XB_XGEN(b.x)]) == gen, bar);
            __builtin_amdgcn_fence(__ATOMIC_ACQUIRE, "agent");
            asm volatile("s_waitcnt vmcnt(0)" ::: "memory");
        }
    }
    __syncthreads();
}

__global__ void __launch_bounds__(512, 2) mk_fwd(Params p) {
  extern __shared__ __attribute__((aligned(16))) unsigned char lds_raw[];
  LAS unsigned char* lds = (LAS unsigned char*)lds_raw;
  cg::grid_group grid = cg::this_grid();
  unsigned char* ws = p.ws;
  const int lo = p.ph_lo, hi = p.ph_hi;
#define IN(k) (lo <= (k) && (k) < hi)
#define SEAM(k) do { if (IN(k) && IN((k) + 1)) xcd_barrier(xbar); } while (0)
  volatile LAS unsigned* xst = (volatile LAS unsigned*)(lds + LDS_BYTES - 16);
  if (threadIdx.x == 0) { xst[0] = 0u; xst[1] = 0u; }
  __syncthreads();
  XcdBarrier xbar; xbar.bar = (unsigned*)(p.ws + OFF_BAR); xbar.x = 0; xbar.st = xst;
  if (hi - lo > 1) xbar = xcd_barrier_post((unsigned*)(p.ws + OFF_BAR), xst);
  if (hi < 0) grid.sync();
  LAS float* Gv = (LAS float*)lds; LAS float* Av = (LAS float*)(lds + 8192); LAS float* Bv = (LAS float*)(lds + 16384);
  bf16_t* U = (bf16_t*)(ws + OFF_U);

  if (IN(0)) {
    phase_mod(p, lds);
    int tb = 0;
    conv_job(p.ffn1_w_in, 2 * DFF, (bf16_t*)(ws + OFF_W1IN), DM, 176, 1, tb, lds);
    conv_job(p.w_in, DIN, (bf16_t*)(ws + OFF_WPA), DM, 65, 2, tb, lds);
    conv_job(p.ffn1_w_out, DM, (bf16_t*)(ws + OFF_W1OUT), DFF, 32, 0, tb, lds);
  }
  SEAM(0);
  int vb = (int)blockIdx.x;
  if (IN(0) && IN(1)) {
    if (threadIdx.x == 0) {
      unsigned* bar = (unsigned*)(p.ws + OFF_BAR); bool ok = (gridDim.x & 7u) == 0u; const unsigned per = gridDim.x >> 3;
      for (unsigned j = 0; j < 16; ++j) { const unsigned c = xb_ld(&bar[XB_XCNT(j)]); if (j < 8 ? c != per : c != 0u) ok = false; }
      xst[3] = ok ? xst[2] * 8u + xbar.x : blockIdx.x;
    }
    __syncthreads();
    vb = (int)xst[3];
  }
  if (IN(1)) {
    for (int r = 0; r < 5; ++r) {
      fill_vecs(p, r, -1, 0.f, 0, 0, 1, 0, Gv, Av, Bv); __syncthreads();
      if (r < 4) rows_norm_mod(p.x + (size_t)r * SEQ * DM, U + (size_t)r * SEQ * DM, SEQ, Av, Bv);
      else rows_norm_mod(p.ctx, U + (size_t)ML * DM, MC, Av, Bv);
      __syncthreads();
    }
  }
  SEAM(1);
  if (IN(2)) { EpiSwiglu E{(bf16_t*)(ws + OFF_ACT)}; run_gemm_v(vb, lds, U, (const bf16_t*)(ws + OFF_W1IN), MT, 2 * DFF, DM, E); __syncthreads(); conv_queue(p, 0, lds); }
  SEAM(2);
  if (IN(3)) {
    { EpiBf16 E{(bf16_t*)(ws + OFF_Y), 8}; run_gemm_v(vb, lds, (const bf16_t*)(ws + OFF_ACT), (const bf16_t*)(ws + OFF_W1OUT), ML, DM, DFF, E); }
    { EpiF32Split E{(float*)(ws + OFF_YC), DM, (size_t)MC * DM}; run_gemm_v(vb, lds, (const bf16_t*)(ws + OFF_ACT) + (size_t)ML * DFF, (const bf16_t*)(ws + OFF_W1OUT), MC, DM, DFF, E, 4); }
    __syncthreads(); conv_queue(p, 0, lds);
  }
  SEAM(3);
  if (IN(4)) {
    conv_queue(p, 0, lds);
    const bf16_t* Y = (const bf16_t*)(ws + OFF_Y);
    for (int r = 0; r < 5; ++r) {
      fill_vecs(p, r, 2, 0.5f, 1, 2, 4, 3, Gv, Av, Bv); __syncthreads();
      if (r < 4) rows_resid<true>(p.x + (size_t)r * SEQ * DM, Y + (size_t)r * SEQ * DM, p.out + (size_t)r * SEQ * DM, U + (size_t)r * SEQ * DM, SEQ, Gv, Av, Bv);
      else rows_resid<true, true>(p.ctx, (const bf16_t*)(ws + OFF_YC), (float*)(ws + OFF_CX1), U + (size_t)ML * DM, MC, Gv, Av, Bv);
      __syncthreads();
    }
  }
  SEAM(4);
  if (IN(5)) { EpiPA E{(bf16_t*)(ws + OFF_Q), (bf16_t*)(ws + OFF_K), (bf16_t*)(ws + OFF_VT), (float*)(ws + OFF_LO)}; run_gemm_v(vb, lds, U, (const bf16_t*)(ws + OFF_WPA), MT, 4352, DM, E); __syncthreads(); conv_queue(p, 1, lds); }
  SEAM(5);
  if (IN(6)) phase_prep(p, lds);
  SEAM(6);
  if (IN(7)) phase_chain(p, lds, vb);
  SEAM(7);
  if (IN(8)) { EpiPB E{(bf16_t*)(ws + OFF_PBC), (bf16_t*)(ws + OFF_PBR), (bf16_t*)(ws + OFF_PBG)}; run_gemm_v(vb, lds, U, (const bf16_t*)(ws + OFF_WPB), ML, 9216, DM, E); }
  SEAM(8);
  if (IN(9)) { conv_queue(p, 1, lds); phase_mix_elem(p); }
  SEAM(9);
  if (IN(10)) { EpiGateT E{(const bf16_t*)(ws + OFF_PBG), (bf16_t*)(ws + OFF_T)}; run_gemm_v(vb, lds, (const bf16_t*)(ws + OFF_ACONV), (const bf16_t*)(ws + OFF_WCO), ML, DM, CONVW, E); }
  if (IN(10) && IN(11)) { asm volatile("s_waitcnt vmcnt(0)" ::: "memory"); __syncthreads(); }
  if (IN(11)) { EpiGateZ E{(const bf16_t*)(ws + OFF_PBG), (const bf16_t*)(ws + OFF_T), (bf16_t*)(ws + OFF_Z)}; run_gemm_v(vb, lds, (const bf16_t*)(ws + OFF_AGLA), (const bf16_t*)(ws + OFF_WGO), ML, DM, DM, E); }
  SEAM(11);
  if (IN(12)) { EpiBf16 E{(bf16_t*)(ws + OFF_Y2), 8}; run_gemm_v(vb, lds, (const bf16_t*)(ws + OFF_Z), (const bf16_t*)(ws + OFF_WO), ML, DM, DM, E); }
  SEAM(12);
  if (IN(13)) {
    const bf16_t* Y = (const bf16_t*)(ws + OFF_Y2);
    for (int r = 0; r < 4; ++r) {
      fill_vecs(p, r, 5, 1.0f, 3, 4, 7, 6, Gv, Av, Bv); __syncthreads();
      rows_resid<true>(p.out + (size_t)r * SEQ * DM, Y + (size_t)r * SEQ * DM, p.out + (size_t)r * SEQ * DM, U + (size_t)r * SEQ * DM, SEQ, Gv, Av, Bv);
      __syncthreads();
    }
  }
  SEAM(13);
  if (IN(14)) { EpiSwiglu E{(bf16_t*)(ws + OFF_ACT)}; run_gemm_v(vb, lds, U, (const bf16_t*)(ws + OFF_W1IN), ML, 2 * DFF, DM, E); }
  SEAM(14);
  if (IN(15)) { EpiBf16 E{(bf16_t*)(ws + OFF_Y), 8}; run_gemm_v(vb, lds, (const bf16_t*)(ws + OFF_ACT), (const bf16_t*)(ws + OFF_W1OUT), ML, DM, DFF, E); }
  SEAM(15);
  if (IN(16)) {
    const bf16_t* Y = (const bf16_t*)(ws + OFF_Y);
    for (int r = 0; r < 4; ++r) {
      fill_vecs(p, r, 8, 0.5f, 5, -1, 0, 0, Gv, Av, Bv); __syncthreads();
      rows_resid<false>(p.out + (size_t)r * SEQ * DM, Y + (size_t)r * SEQ * DM, p.out + (size_t)r * SEQ * DM, nullptr, SEQ, Gv, Av, Bv);
      __syncthreads();
    }
  }
}
constexpr int NPHASE = 17;

extern "C" void kernel_launch(void* const* d_in, const int* in_sizes, int n_in, void* d_out, int out_size, void* d_ws, size_t ws_size, hipStream_t stream) {
  static int grid_blocks = 0;
  if (!grid_blocks) {
    int dev = 0, cus = 0, per_cu = 0;
    (void)hipGetDevice(&dev);
    (void)hipDeviceGetAttribute(&cus, hipDeviceAttributeMultiprocessorCount, dev);
    (void)hipFuncSetAttribute((const void*)mk_fwd, hipFuncAttributeMaxDynamicSharedMemorySize, LDS_BYTES);
    (void)hipOccupancyMaxActiveBlocksPerMultiprocessor(&per_cu, mk_fwd, 512, LDS_BYTES);
    if (per_cu < 1) { fprintf(stderr, "kernel_launch: occupancy query returned %d\n", per_cu); per_cu = 1; }
    grid_blocks = cus;
  }
  if (ws_size < WS_NEED) { fprintf(stderr, "kernel_launch: workspace too small (%zu < %zu)\n", ws_size, (size_t)WS_NEED); return; }
  Params p{};
  const float** pp = (const float**)&p;
  for (int i = 0; i < 20; ++i) pp[i] = (const float*)d_in[i];
  p.out = (float*)d_out; p.ws = (unsigned char*)d_ws;
#if MULTI_LAUNCH
  for (int ph = 0; ph < NPHASE; ++ph) { p.ph_lo = ph; p.ph_hi = ph + 1; hipLaunchKernelGGL(mk_fwd, dim3(grid_blocks), dim3(512), LDS_BYTES, stream, p); }
#else
  p.ph_lo = 0; p.ph_hi = NPHASE;
  (void)hipMemsetAsync((unsigned char*)d_ws + OFF_BAR, 0, (XCD_BAR_WORDS + 256) * 4, stream);
  void* args[] = {&p};
  hipError_t e = hipLaunchCooperativeKernel((void*)mk_fwd, dim3(grid_blocks), dim3(512), args, LDS_BYTES, stream);
  if (e != hipSuccess) fprintf(stderr, "cooperative launch failed: %s (grid %d)\n", hipGetErrorString(e), grid_blocks);
#endif
}
```

```cpp
#include <hip/hip_runtime.h>
#include <hip/hip_cooperative_groups.h>
#include <cstdio>
namespace cg = cooperative_groups;
#ifndef MULTI_LAUNCH
#define MULTI_LAUNCH 0
#endif
#define LAS __attribute__((address_space(3)))
typedef unsigned short bf16_t;
typedef short bf16x8 __attribute__((ext_vector_type(8)));
typedef float f32x4 __attribute__((ext_vector_type(4)));
typedef unsigned u32x4 __attribute__((ext_vector_type(4)));
typedef unsigned u32x2 __attribute__((ext_vector_type(2)));

constexpr int DM = 2048, NB = 4, SEQ = 4096, CTXL = 256, DFF = 5632, CONVW = 1024, NH = 4, HK = 256, HV = 512;
constexpr int ML = NB * SEQ, MC = NB * CTXL, MT = ML + MC;
constexpr int DIN = 13344, NMODC = 9 * DM;
constexpr int KSPLIT = 8;
constexpr float EPS = 1e-6f;
constexpr size_t MiB = 1048576;
constexpr size_t OFF_W1IN = 0, OFF_W1OUT = 44 * MiB, OFF_WPA = 66 * MiB, OFF_WPB = 83 * MiB, OFF_WCO = 119 * MiB, OFF_WGO = 123 * MiB, OFF_WO = 131 * MiB;
constexpr size_t OFF_U = 139 * MiB, OFF_R = 207 * MiB;
constexpr size_t OFF_ACT = OFF_R, OFF_Y = 394 * MiB, OFF_YC = 530 * MiB;
constexpr size_t OFF_Q = 207 * MiB, OFF_K = 241 * MiB, OFF_VT = 275 * MiB, OFF_QD = 343 * MiB, OFF_KDT = 407 * MiB, OFF_PS = 475 * MiB, OFF_OF = 495 * MiB, OFF_OB = 559 * MiB;
constexpr size_t OFF_PBC = 207 * MiB, OFF_PBR = 303 * MiB, OFF_PBG = 367 * MiB, OFF_T = 495 * MiB, OFF_Z = OFF_PBR, OFF_Y2 = 495 * MiB;
constexpr size_t OFF_ACONV = 66 * MiB, OFF_AGLA = OFF_U;
constexpr size_t OFF_MODF = 624 * MiB;
constexpr size_t OFF_MODP = 640 * MiB, OFF_CX1 = 643 * MiB, OFF_LO = 651 * MiB, OFF_AL = 654 * MiB, OFF_BAR = 657 * MiB, WS_NEED = 658 * MiB;
constexpr int LDS_BYTES = 160 * 1024;

struct Params {
  const float *x, *c, *ctx, *c_ctx, *w_mod, *b_mod, *norm_g, *ffn1_w_in, *ffn1_w_out, *w_in, *conv_w, *conv_b, *conv_out, *gate_up, *gate_bias, *gla_norm_g, *gla_out, *w_o, *ffn2_w_in, *ffn2_w_out;
  float* out; unsigned char* ws; int ph_lo, ph_hi;
};

typedef float f32x2 __attribute__((ext_vector_type(2)));
typedef __bf16 bf16x2_t __attribute__((ext_vector_type(2)));
__device__ __forceinline__ unsigned cvt_pk_bf16(float lo, float hi) { const f32x2 v = {lo, hi}; return __builtin_bit_cast(unsigned, __builtin_convertvector(v, bf16x2_t)); }
__device__ __forceinline__ float bf_lo(unsigned w) { return __uint_as_float(w << 16); }
__device__ __forceinline__ float bf_hi(unsigned w) { return __uint_as_float(w & 0xffff0000u); }
__device__ __forceinline__ float fsigmoid(float v) { return __builtin_amdgcn_rcpf(1.0f + __expf(-v)); }
__device__ __forceinline__ float fsilu(float v) { return v * fsigmoid(v); }
__device__ __forceinline__ float wave_sum(float v) {
#pragma unroll
  for (int o = 32; o >= 1; o >>= 1) v += __shfl_xor(v, o);
  return v;
}

namespace pg8 {
constexpr int BM = 256, BK = 64, HALF = 128, HTB = HALF * BK * 2, STAGE_BYTES = 8 * HTB, NXCD = 8, WGM = 8;
__host__ __device__ __forceinline__ int lds_byte(int r, int c) { const int st = (r >> 4) * 2 + (c >> 5), rr = r & 15, cc = c & 31, ob = rr * 64 + cc * 2; return st * 1024 + (ob ^ (((ob >> 9) & 1) << 5)); }
__host__ __device__ __forceinline__ void stage_rc(int b, int& R, int& C) { const int st = b / 1024, sb = b % 1024, swz = sb ^ (((sb >> 9) & 1) << 5); R = (st >> 1) * 16 + swz / 64; C = (st & 1) * 32 + (swz % 64) / 2; }
__host__ __device__ __forceinline__ int perm32(int rho) { const int n = rho >> 4, i = rho & 15; return 8 * (i >> 2) + 4 * n + (i & 3); }
struct Unit { int pm, pn, ks; };
struct Gemm { const bf16_t* A; const bf16_t* Bt; int M, N, K, ld; };
struct StaticOrder {
  int nM, nN, nwg, G, c, nsplit;
  __device__ void init(int M, int N, int G_, int c_, int nsplit_ = 1) { nM = M / BM; nN = N / BM; nwg = nM * nN; G = G_; c = c_; nsplit = nsplit_; }
  __device__ bool next(int i, Unit& u) const {
    const long L = (long)i * G + c; if (L >= (long)nwg * nsplit) return false;
    u.ks = (int)(L / nwg);
    int wgid = (int)(L % nwg); { const int q = nwg / NXCD, r = nwg % NXCD, xcd = wgid % NXCD, off = wgid / NXCD; wgid = (xcd < r ? xcd * (q + 1) : r * (q + 1) + (xcd - r) * q) + off; }
    const int nig = WGM * nN, gid = wgid / nig, fm = gid * WGM, gsz = (nM - fm) < WGM ? (nM - fm) : WGM;
    u.pm = fm + ((wgid % nig) % gsz); u.pn = (wgid % nig) / gsz; return true;
  }
};

template <class Epi>
__device__ __forceinline__ void gemm_phase(LAS unsigned char* lds, const Gemm g, const StaticOrder& S, const Epi& E) {
  const int tid = threadIdx.x, wid = __builtin_amdgcn_readfirstlane(tid >> 6), lane = tid & 63, wr = wid >> 2, wc = wid & 3, fr = lane & 15, fq = lane >> 4;
  const int K = g.K, nt = K / BK, ld = g.ld;
  unsigned voffA[2], voffB[2];
#pragma unroll
  for (int i = 0; i < 2; ++i) { int R, C; stage_rc(tid * 16 + i * 8192, R, C); const int Rb = Epi::PERM ? ((R & ~31) + perm32(R & 31)) : R;
    voffA[i] = (unsigned)(R * ld + C) * 2u; voffB[i] = (unsigned)(Rb * ld + C) * 2u; }
  const size_t kstep = (size_t)(BK * 2);
  const size_t hstep = (size_t)HALF * ld * 2;
  const size_t sstep = (size_t)K * 2;
  const size_t tstep = 2 * hstep;
  const unsigned ldsw = (unsigned)wid * 1024u;
  const int aoff = lds_byte(wr * 64 + fr, fq * 8), boff = lds_byte(wc * 32 + fr, fq * 8);
#define PG8_SA(b, h) (((b) * 2 + (h)) * HTB)
#define PG8_SB(b, h) ((4 + (b) * 2 + (h)) * HTB)
#define PG8_STAGE(bufoff, gbase, voff) do { _Pragma("unroll") for (int _i = 0; _i < 2; ++_i) \
    __builtin_amdgcn_global_load_lds((const unsigned*)((const char*)(gbase) + (voff)[_i]), (LAS unsigned*)(lds + (bufoff) + ldsw + _i * 8192), 16, 0, 0); } while (0)
#define PG8_LDA(dst, b, h) do { _Pragma("unroll") for (int m = 0; m < 4; ++m) _Pragma("unroll") for (int k = 0; k < 2; ++k) dst[m][k] = *(const LAS bf16x8*)(lds + PG8_SA(b, h) + aoff + m * 2048 + k * 1024); } while (0)
#define PG8_LDB(dst, b, h) do { _Pragma("unroll") for (int n = 0; n < 2; ++n) _Pragma("unroll") for (int k = 0; k < 2; ++k) dst[n][k] = *(const LAS bf16x8*)(lds + PG8_SB(b, h) + boff + n * 2048 + k * 1024); } while (0)
#define PG8_MMA(ai, bj, At, Bt) do { __builtin_amdgcn_s_setprio(1); _Pragma("unroll") for (int m = 0; m < 4; ++m) _Pragma("unroll") for (int n = 0; n < 2; ++n) _Pragma("unroll") for (int k = 0; k < 2; ++k) \
    acc[ai][bj][m][n] = __builtin_amdgcn_mfma_f32_16x16x32_bf16(Bt[n][k], At[m][k], acc[ai][bj][m][n], 0, 0, 0); __builtin_amdgcn_s_setprio(0); } while (0)
#define PG8_WAIT_V(n) asm volatile("s_waitcnt vmcnt(" #n ")" ::: "memory")
#define PG8_WAIT_L(n) asm volatile("s_waitcnt lgkmcnt(" #n ")" ::: "memory")
#define PG8_BAR __builtin_amdgcn_s_barrier()
#define PG8_SCHED __builtin_amdgcn_sched_barrier(0)
  Unit cur, nxt; int ui = 0;
  if (!S.next(0, cur)) return;
  f32x4 acc[2][2][4][2];
#pragma unroll
  for (int a = 0; a < 2; ++a)
#pragma unroll
    for (int b = 0; b < 2; ++b)
#pragma unroll
      for (int m = 0; m < 4; ++m)
#pragma unroll
        for (int n = 0; n < 2; ++n) acc[a][b][m][n] = (f32x4){0.f, 0.f, 0.f, 0.f};
  bf16x8 At[4][2], B0[2][2], B1[2][2];
  const char* cA = (const char*)g.A + (size_t)cur.pm * tstep + (size_t)cur.ks * sstep; const char* cB = (const char*)g.Bt + (size_t)cur.pn * tstep + (size_t)cur.ks * sstep;
  PG8_STAGE(PG8_SB(0, 0), cB, voffB); PG8_STAGE(PG8_SA(0, 0), cA, voffA); PG8_STAGE(PG8_SB(0, 1), cB + hstep, voffB); PG8_STAGE(PG8_SA(0, 1), cA + hstep, voffA);
  if (wr == 1) PG8_BAR;
  PG8_WAIT_V(4); PG8_BAR;
  PG8_STAGE(PG8_SB(1, 0), cB + kstep, voffB); PG8_STAGE(PG8_SA(1, 0), cA + kstep, voffA); PG8_STAGE(PG8_SB(1, 1), cB + hstep + kstep, voffB);
  PG8_WAIT_V(6); PG8_BAR;
  for (;;) {
    const bool has_next = S.next(ui + 1, nxt);
    const char* nA = has_next ? (const char*)g.A + (size_t)nxt.pm * tstep + (size_t)nxt.ks * sstep : cA; const char* nB = has_next ? (const char*)g.Bt + (size_t)nxt.pn * tstep + (size_t)nxt.ks * sstep : cB;
    for (int t = 0; t < nt; t += 2) {
      const bool last = (t == nt - 2);
      const char* a1 = cA + (size_t)(t + 1) * kstep;
      const char* a2 = last ? nA : cA + (size_t)(t + 2) * kstep; const char* b2 = last ? nB : cB + (size_t)(t + 2) * kstep;
      const char* a3 = a2 + kstep; const char* b3 = b2 + kstep;
      PG8_LDB(B0, 0, 0); PG8_SCHED; PG8_LDA(At, 0, 0); PG8_STAGE(PG8_SA(1, 1), a1 + hstep, voffA);
      PG8_WAIT_L(8); PG8_BAR; PG8_WAIT_L(0); PG8_MMA(0, 0, At, B0); PG8_BAR; PG8_SCHED;
      PG8_LDB(B1, 0, 1); PG8_STAGE(PG8_SB(0, 0), b2, voffB);
      PG8_BAR; PG8_WAIT_L(0); PG8_MMA(0, 1, At, B1); PG8_BAR;
      PG8_LDA(At, 0, 1); PG8_STAGE(PG8_SA(0, 0), a2, voffA);
      PG8_BAR; PG8_WAIT_L(0); PG8_MMA(1, 0, At, B0); PG8_BAR; PG8_SCHED;
      PG8_STAGE(PG8_SB(0, 1), b2 + hstep, voffB);
      PG8_WAIT_V(6); PG8_BAR; PG8_MMA(1, 1, At, B1); PG8_BAR;
      PG8_LDB(B0, 1, 0); PG8_SCHED; PG8_LDA(At, 1, 0); PG8_STAGE(PG8_SA(0, 1), a2 + hstep, voffA);
      PG8_WAIT_L(8); PG8_BAR; PG8_WAIT_L(0); PG8_MMA(0, 0, At, B0); PG8_BAR; PG8_SCHED;
      PG8_LDB(B1, 1, 1); PG8_STAGE(PG8_SB(1, 0), b3, voffB);
      PG8_BAR; PG8_WAIT_L(0); PG8_MMA(0, 1, At, B1); PG8_BAR;
      PG8_LDA(At, 1, 1); PG8_STAGE(PG8_SA(1, 0), a3, voffA);
      PG8_BAR; PG8_WAIT_L(0); PG8_MMA(1, 0, At, B0); PG8_BAR; PG8_SCHED;
      PG8_STAGE(PG8_SB(1, 1), b3 + hstep, voffB);
      PG8_WAIT_V(6); PG8_BAR; PG8_MMA(1, 1, At, B1); PG8_BAR;
    }
    E(acc, cur, wr, wc, fr, fq);
    if (!has_next) break;
#pragma unroll
    for (int a = 0; a < 2; ++a)
#pragma unroll
      for (int b = 0; b < 2; ++b)
#pragma unroll
        for (int m = 0; m < 4; ++m)
#pragma unroll
          for (int n = 0; n < 2; ++n) acc[a][b][m][n] = (f32x4){0.f, 0.f, 0.f, 0.f};
    cur = nxt; cA = nA; cB = nB; ++ui;
  }
  PG8_WAIT_V(0);
  if (wr == 0) PG8_BAR;
  PG8_BAR;
#undef PG8_SA
#undef PG8_SB
#undef PG8_STAGE
#undef PG8_LDA
#undef PG8_LDB
#undef PG8_MMA
#undef PG8_WAIT_V
#undef PG8_WAIT_L
#undef PG8_BAR
#undef PG8_SCHED
}
}
using pg8::Unit;
typedef f32x4 AccT[2][2][4][2];

struct EpiSwiglu {
  static constexpr bool PERM = true; bf16_t* O;
  __device__ __forceinline__ void operator()(const AccT& acc, const Unit& u, int wr, int wc, int fr, int fq) const {
    const int row0 = u.pm * 256 + wr * 64 + fr, col0 = u.pn * 128 + wc * 32 + 8 * fq;
#pragma unroll
    for (int ai = 0; ai < 2; ++ai)
#pragma unroll
      for (int m = 0; m < 4; ++m) {
        bf16_t* rowp = O + (size_t)(row0 + ai * 128 + m * 16) * DFF + col0;
        float h[8];
#pragma unroll
        for (int n = 0; n < 2; ++n)
#pragma unroll
          for (int j = 0; j < 4; ++j) { const float a = acc[ai][0][m][n][j], b = acc[ai][1][m][n][j]; h[n * 4 + j] = a * fsilu(b); }
        u32x4 w; w.x = cvt_pk_bf16(h[0], h[1]); w.y = cvt_pk_bf16(h[2], h[3]); w.z = cvt_pk_bf16(h[4], h[5]); w.w = cvt_pk_bf16(h[6], h[7]);
        *(u32x4*)rowp = w;
      }
  }
};
struct EpiF32 {
  static constexpr bool PERM = false; float* C; int ldc;
  __device__ __forceinline__ void operator()(const AccT& acc, const Unit& u, int wr, int wc, int fr, int fq) const {
    const int row0 = u.pm * 256 + wr * 64 + fr, col0 = u.pn * 256 + wc * 32 + 4 * fq;
#pragma unroll
    for (int ai = 0; ai < 2; ++ai)
#pragma unroll
      for (int m = 0; m < 4; ++m) { float* rowp = C + (size_t)(row0 + ai * 128 + m * 16) * ldc + col0;
#pragma unroll
        for (int bj = 0; bj < 2; ++bj)
#pragma unroll
          for (int n = 0; n < 2; ++n) *(f32x4*)(rowp + bj * 128 + n * 16) = acc[ai][bj][m][n]; }
  }
};
struct EpiBf16 {
  static constexpr bool PERM = true; bf16_t* O; int nT;
  __device__ __forceinline__ void operator()(const AccT& acc, const Unit& u, int wr, int wc, int fr, int fq) const {
    bf16_t* base = O + ((size_t)(u.pm * nT + u.pn) << 16) + (wr * 64 + fr) * 256 + wc * 32 + 8 * fq;
#pragma unroll
    for (int ai = 0; ai < 2; ++ai)
#pragma unroll
      for (int m = 0; m < 4; ++m) { bf16_t* rowp = base + (ai * 128 + m * 16) * 256;
#pragma unroll
        for (int bj = 0; bj < 2; ++bj) { const f32x4 v0 = acc[ai][bj][m][0], v1 = acc[ai][bj][m][1];
          u32x4 w; w.x = cvt_pk_bf16(v0[0], v0[1]); w.y = cvt_pk_bf16(v0[2], v0[3]); w.z = cvt_pk_bf16(v1[0], v1[1]); w.w = cvt_pk_bf16(v1[2], v1[3]);
          *(u32x4*)(rowp + bj * 128) = w; } }
  }
};
struct EpiF32Split {
  static constexpr bool PERM = false; float* C; int ldc; size_t slab;
  __device__ __forceinline__ void operator()(const AccT& acc, const Unit& u, int wr, int wc, int fr, int fq) const {
    const int row0 = u.pm * 256 + wr * 64 + fr, col0 = u.pn * 256 + wc * 32 + 4 * fq; float* base = C + (size_t)u.ks * slab;
#pragma unroll
    for (int ai = 0; ai < 2; ++ai)
#pragma unroll
      for (int m = 0; m < 4; ++m) { float* rowp = base + (size_t)(row0 + ai * 128 + m * 16) * ldc + col0;
#pragma unroll
        for (int bj = 0; bj < 2; ++bj)
#pragma unroll
          for (int n = 0; n < 2; ++n) *(f32x4*)(rowp + bj * 128 + n * 16) = acc[ai][bj][m][n]; }
  }
};
struct EpiPA {
  static constexpr bool PERM = true; bf16_t *Q, *K, *VT; float* LO;
  __device__ __forceinline__ void operator()(const AccT& acc, const Unit& u, int wr, int wc, int fr, int fq) const {
    const int row0 = u.pm * 256 + wr * 64 + fr;
    if (u.pn < 8) {
      bf16_t* base = (u.pn < 4 ? Q : K) + ((size_t)(u.pm * 4 + (u.pn & 3)) << 16) + (wr * 64 + fr) * 256 + wc * 32 + 8 * fq;
#pragma unroll
      for (int ai = 0; ai < 2; ++ai)
#pragma unroll
        for (int m = 0; m < 4; ++m) { bf16_t* rowp = base + (ai * 128 + m * 16) * 256;
#pragma unroll
          for (int bj = 0; bj < 2; ++bj) { const f32x4 v0 = acc[ai][bj][m][0], v1 = acc[ai][bj][m][1];
            u32x4 w; w.x = cvt_pk_bf16(v0[0], v0[1]); w.y = cvt_pk_bf16(v0[2], v0[3]); w.z = cvt_pk_bf16(v1[0], v1[1]); w.w = cvt_pk_bf16(v1[2], v1[3]);
            *(u32x4*)(rowp + bj * 128) = w; } }
    } else if (u.pn < 16) {
      const int hv0 = (u.pn - 8) * 256 + wc * 32 + 8 * fq;
#pragma unroll
      for (int ai = 0; ai < 2; ++ai)
#pragma unroll
        for (int m = 0; m < 4; ++m) { const int row = row0 + ai * 128 + m * 16; const int gid = row >> 6, s = row & 63;
          bf16_t* bp = VT + ((size_t)gid * 2048 + hv0) * 64 + s;
#pragma unroll
          for (int bj = 0; bj < 2; ++bj)
#pragma unroll
            for (int n = 0; n < 2; ++n) { const f32x4 v = acc[ai][bj][m][n]; const unsigned w0 = cvt_pk_bf16(v[0], v[1]), w1 = cvt_pk_bf16(v[2], v[3]);
              bf16_t* q = bp + (size_t)(bj * 128 + 4 * n) * 64;
              q[0] = (bf16_t)(w0 & 0xffffu); q[64] = (bf16_t)(w0 >> 16); q[128] = (bf16_t)(w1 & 0xffffu); q[192] = (bf16_t)(w1 >> 16); } }
    } else {
      if (wc == 0) {
#pragma unroll
        for (int ai = 0; ai < 2; ++ai)
#pragma unroll
          for (int m = 0; m < 4; ++m) { float* rowp = LO + (size_t)(row0 + ai * 128 + m * 16) * 32 + 8 * fq;
            *(f32x4*)rowp = acc[ai][0][m][0]; *(f32x4*)(rowp + 4) = acc[ai][0][m][1]; }
      }
    }
  }
};
struct EpiPB {
  static constexpr bool PERM = true; bf16_t *PBc, *PBr, *PBg;
  __device__ __forceinline__ void operator()(const AccT& acc, const Unit& u, int wr, int wc, int fr, int fq) const {
    bf16_t* buf; int nT, pl;
    if (u.pn < 12) { buf = PBc; nT = 12; pl = u.pn; } else if (u.pn < 20) { buf = PBr; nT = 8; pl = u.pn - 12; } else { buf = PBg; nT = 16; pl = u.pn - 20; }
    bf16_t* base = buf + ((size_t)(u.pm * nT + pl) << 16) + (wr * 64 + fr) * 256 + wc * 32 + 8 * fq;
#pragma unroll
    for (int ai = 0; ai < 2; ++ai)
#pragma unroll
      for (int m = 0; m < 4; ++m) { bf16_t* rowp = base + (ai * 128 + m * 16) * 256;
#pragma unroll
        for (int bj = 0; bj < 2; ++bj) { const f32x4 v0 = acc[ai][bj][m][0], v1 = acc[ai][bj][m][1];
          u32x4 w; w.x = cvt_pk_bf16(v0[0], v0[1]); w.y = cvt_pk_bf16(v0[2], v0[3]); w.z = cvt_pk_bf16(v1[0], v1[1]); w.w = cvt_pk_bf16(v1[2], v1[3]);
          *(u32x4*)(rowp + bj * 128) = w; } }
  }
};
struct EpiGateT {
  static constexpr bool PERM = true; const bf16_t* PBg; bf16_t* T;
  __device__ __forceinline__ void operator()(const AccT& acc, const Unit& u, int wr, int wc, int fr, int fq) const {
    const int toff = (wr * 64 + fr) * 256 + wc * 32 + 8 * fq;
    const bf16_t* gb = PBg + ((size_t)(u.pm * 16 + u.pn) << 16) + toff; bf16_t* tb = T + ((size_t)(u.pm * 8 + u.pn) << 16) + toff;
#pragma unroll
    for (int ai = 0; ai < 2; ++ai) {
      u32x4 g[4][2];
#pragma unroll
      for (int m = 0; m < 4; ++m)
#pragma unroll
        for (int bj = 0; bj < 2; ++bj) g[m][bj] = *(const u32x4*)(gb + (ai * 128 + m * 16) * 256 + bj * 128);
#pragma unroll
      for (int m = 0; m < 4; ++m)
#pragma unroll
        for (int bj = 0; bj < 2; ++bj) { const u32x4 gg = g[m][bj]; const f32x4 a0 = acc[ai][bj][m][0], a1 = acc[ai][bj][m][1];
          float z[8];
          z[0] = a0[0] * fsigmoid(bf_lo(gg.x)); z[1] = a0[1] * fsigmoid(bf_hi(gg.x)); z[2] = a0[2] * fsigmoid(bf_lo(gg.y)); z[3] = a0[3] * fsigmoid(bf_hi(gg.y));
          z[4] = a1[0] * fsigmoid(bf_lo(gg.z)); z[5] = a1[1] * fsigmoid(bf_hi(gg.z)); z[6] = a1[2] * fsigmoid(bf_lo(gg.w)); z[7] = a1[3] * fsigmoid(bf_hi(gg.w));
          u32x4 w; w.x = cvt_pk_bf16(z[0], z[1]); w.y = cvt_pk_bf16(z[2], z[3]); w.z = cvt_pk_bf16(z[4], z[5]); w.w = cvt_pk_bf16(z[6], z[7]);
          *(u32x4*)(tb + (ai * 128 + m * 16) * 256 + bj * 128) = w; }
    }
  }
};
struct EpiGateZ {
  static constexpr bool PERM = true; const bf16_t* PBg; const bf16_t* T; bf16_t* Z;
  __device__ __forceinline__ void operator()(const AccT& acc, const Unit& u, int wr, int wc, int fr, int fq) const {
    const int row0 = u.pm * 256 + wr * 64 + fr, col0 = u.pn * 256 + wc * 32 + 8 * fq;
    const int toff = (wr * 64 + fr) * 256 + wc * 32 + 8 * fq;
    const bf16_t* gb = PBg + ((size_t)(u.pm * 16 + 8 + u.pn) << 16) + toff; const bf16_t* tb = T + ((size_t)(u.pm * 8 + u.pn) << 16) + toff;
#pragma unroll
    for (int ai = 0; ai < 2; ++ai) {
      u32x4 g[4][2], tt[4][2];
#pragma unroll
      for (int m = 0; m < 4; ++m)
#pragma unroll
        for (int bj = 0; bj < 2; ++bj) { g[m][bj] = *(const u32x4*)(gb + (ai * 128 + m * 16) * 256 + bj * 128); tt[m][bj] = *(const u32x4*)(tb + (ai * 128 + m * 16) * 256 + bj * 128); }
#pragma unroll
      for (int m = 0; m < 4; ++m) { const size_t row = (size_t)(row0 + ai * 128 + m * 16);
#pragma unroll
        for (int bj = 0; bj < 2; ++bj) { const int col = col0 + bj * 128; const u32x4 gg = g[m][bj], tw = tt[m][bj]; const f32x4 a0 = acc[ai][bj][m][0], a1 = acc[ai][bj][m][1];
          float z[8];
          z[0] = bf_lo(tw.x) + a0[0] * fsigmoid(bf_lo(gg.x)); z[1] = bf_hi(tw.x) + a0[1] * fsigmoid(bf_hi(gg.x)); z[2] = bf_lo(tw.y) + a0[2] * fsigmoid(bf_lo(gg.y)); z[3] = bf_hi(tw.y) + a0[3] * fsigmoid(bf_hi(gg.y));
          z[4] = bf_lo(tw.z) + a1[0] * fsigmoid(bf_lo(gg.z)); z[5] = bf_hi(tw.z) + a1[1] * fsigmoid(bf_hi(gg.z)); z[6] = bf_lo(tw.w) + a1[2] * fsigmoid(bf_lo(gg.w)); z[7] = bf_hi(tw.w) + a1[3] * fsigmoid(bf_hi(gg.w));
          u32x4 w; w.x = cvt_pk_bf16(z[0], z[1]); w.y = cvt_pk_bf16(z[2], z[3]); w.z = cvt_pk_bf16(z[4], z[5]); w.w = cvt_pk_bf16(z[6], z[7]);
          *(u32x4*)(Z + row * 2048 + col) = w; } }
    }
  }
};

template <class Epi>
__device__ __forceinline__ void run_gemm_v(int vb, LAS unsigned char* lds, const bf16_t* A, const bf16_t* Bt, int M, int N, int K, const Epi& E, int nsplit = 1) {
  pg8::Gemm g{A, Bt, M, N, K / nsplit, K}; pg8::StaticOrder S; S.init(M, N, (int)gridDim.x, vb, nsplit);
  pg8::gemm_phase<Epi>(lds, g, S, E);
}

__device__ __forceinline__ void phase_mod(const Params& p, LAS unsigned char* lds) {
  LAS float* sv = (LAS float*)lds;
  LAS float* red = (LAS float*)(lds + 8192);
  float* MODP = (float*)(p.ws + OFF_MODP);
  const int tid = threadIdx.x, wid = tid >> 6, lane = tid & 63;
  for (int item = blockIdx.x; item < 72 * KSPLIT; item += gridDim.x) {
    const int cc = item % 72, ks = item / 72;
    for (int i = tid; i < 5 * 256; i += 512) { const int r = i >> 8, k = ks * 256 + (i & 255); const float v = r < 4 ? p.c[r * DM + k] : p.c_ctx[k]; sv[i] = v / (1.f + __expf(-v)); }
    __syncthreads();
    f32x4 a0 = {0, 0, 0, 0}, a1 = a0, a2 = a0, a3 = a0, a4 = a0;
    const float* wp = p.w_mod + (size_t)(ks * 256 + wid * 32) * NMODC + cc * 256 + lane * 4;
#pragma unroll 8
    for (int k = 0; k < 32; ++k) {
      const f32x4 w = __builtin_nontemporal_load((const f32x4*)(wp + (size_t)k * NMODC));
      const int kk = wid * 32 + k;
      a0 += w * sv[kk]; a1 += w * sv[256 + kk]; a2 += w * sv[512 + kk]; a3 += w * sv[768 + kk]; a4 += w * sv[1024 + kk];
    }
    *(LAS f32x4*)(red + (wid * 5 + 0) * 256 + lane * 4) = a0; *(LAS f32x4*)(red + (wid * 5 + 1) * 256 + lane * 4) = a1; *(LAS f32x4*)(red + (wid * 5 + 2) * 256 + lane * 4) = a2;
    *(LAS f32x4*)(red + (wid * 5 + 3) * 256 + lane * 4) = a3; *(LAS f32x4*)(red + (wid * 5 + 4) * 256 + lane * 4) = a4;
    __syncthreads();
    for (int i = tid; i < 1280; i += 512) { const int r = i >> 8, col = i & 255; float s = 0.f;
#pragma unroll
      for (int w = 0; w < 8; ++w) s += red[(w * 5 + r) * 256 + col];
      if (ks == 0) s += p.b_mod[cc * 256 + col];
      MODP[(size_t)(ks * 5 + r) * NMODC + cc * 256 + col] = s; }
    __syncthreads();
  }
}
__device__ __forceinline__ float modsum(const float* MODP, int r, int idx) { float s = 0.f;
#pragma unroll
  for (int ks = 0; ks < KSPLIT; ++ks) s += MODP[(size_t)(ks * 5 + r) * NMODC + idx];
  return s; }

__device__ __forceinline__ void conv_tile(const float* src, int ldsrc, int sc0, bf16_t* dst, int K, int nd0, int k0, LAS unsigned char* lds) {
  LAS unsigned* T = (LAS unsigned*)lds;
  const int tid = threadIdx.x, nq = tid & 15, kp = tid >> 4;
#pragma unroll
  for (int pass = 0; pass < 2; ++pass) {
    const int kk = (pass * 32 + kp) * 2;
    const float* s0 = src + (size_t)(k0 + kk) * ldsrc + sc0 + nq * 4;
    const f32x4 a = __builtin_nontemporal_load((const f32x4*)s0), b = __builtin_nontemporal_load((const f32x4*)(s0 + ldsrc));
#pragma unroll
    for (int j = 0; j < 4; ++j) T[(nq * 4 + j) * 65 + pass * 32 + kp] = cvt_pk_bf16(a[j], b[j]);
  }
  __syncthreads();
  { const int row = tid >> 3, seg = tid & 7; u32x4 w0, w1;
    w0.x = T[row * 65 + seg * 8 + 0]; w0.y = T[row * 65 + seg * 8 + 1]; w0.z = T[row * 65 + seg * 8 + 2]; w0.w = T[row * 65 + seg * 8 + 3];
    w1.x = T[row * 65 + seg * 8 + 4]; w1.y = T[row * 65 + seg * 8 + 5]; w1.z = T[row * 65 + seg * 8 + 6]; w1.w = T[row * 65 + seg * 8 + 7];
    bf16_t* d = dst + (size_t)(nd0 + row) * K + k0 + seg * 16;
    *(u32x4*)d = w0; *(u32x4*)(d + 8) = w1; }
  __syncthreads();
}
__device__ __forceinline__ void conv_job(const float* src, int ldsrc, bf16_t* dst, int K, int ngroups, int map, int& tbase, LAS unsigned char* lds) {
  const int nk = K >> 7, nt = ngroups * nk, G = (int)gridDim.x;
  int t = ((int)blockIdx.x - (tbase % G) + G) % G;
  for (; t < nt; t += G) {
    const int ng = t / nk, kt = t - ng * nk, nd0 = ng * 64; int sc0;
    if (map == 0) sc0 = nd0;
    else if (map == 1) sc0 = ((nd0 & 255) >> 7) * DFF + (nd0 >> 8) * 128 + (nd0 & 127);
    else if (map == 2) sc0 = nd0 < 4096 ? 3072 + nd0 : 9216 + (nd0 - 4096);
    else sc0 = nd0 < 3072 ? nd0 : (nd0 < 5120 ? 7168 + (nd0 - 3072) : 9248 + (nd0 - 5120));
    conv_tile(src, ldsrc, sc0, dst, K, nd0, kt * 128, lds);
  }
  tbase += nt;
}

__device__ __forceinline__ void conv_queue(const Params& p, int q, LAS unsigned char* lds) {
  LAS unsigned* slot = (LAS unsigned*)(lds + 20480);
  unsigned* counter = (unsigned*)(p.ws + OFF_BAR) + 3456 + 64 + 64 * q;
  const int total = q == 0 ? 3584 : 4224;
  for (;;) {
    if (threadIdx.x == 0) slot[0] = __hip_atomic_fetch_add(counter, 1u, __ATOMIC_RELAXED, __HIP_MEMORY_SCOPE_AGENT);
    __syncthreads();
    int t = (int)slot[0];
    __syncthreads();
    if (t >= total) break;
    const float* src; bf16_t* dst; int ldsrc, K, map;
    if (q == 0) {
      if (t < 2304) { src = p.w_in; dst = (bf16_t*)(p.ws + OFF_WPB); ldsrc = DIN; K = DM; map = 3; }
      else if (t < 2560) { t -= 2304; src = p.conv_out; dst = (bf16_t*)(p.ws + OFF_WCO); ldsrc = DM; K = CONVW; map = 0; }
      else if (t < 3072) { t -= 2560; src = p.gla_out; dst = (bf16_t*)(p.ws + OFF_WGO); ldsrc = DM; K = DM; map = 0; }
      else { t -= 3072; src = p.w_o; dst = (bf16_t*)(p.ws + OFF_WO); ldsrc = DM; K = DM; map = 0; }
    } else {
      if (t < 2816) { src = p.ffn2_w_in; dst = (bf16_t*)(p.ws + OFF_W1IN); ldsrc = 2 * DFF; K = DM; map = 1; }
      else { t -= 2816; src = p.ffn2_w_out; dst = (bf16_t*)(p.ws + OFF_W1OUT); ldsrc = DM; K = DFF; map = 0; }
    }
    const int nk = K >> 7, ng = t / nk, kt = t - ng * nk, nd0 = ng * 64; int sc0;
    if (map == 0) sc0 = nd0;
    else if (map == 1) sc0 = ((nd0 & 255) >> 7) * DFF + (nd0 >> 8) * 128 + (nd0 & 127);
    else sc0 = nd0 < 3072 ? nd0 : (nd0 < 5120 ? 7168 + (nd0 - 3072) : 9248 + (nd0 - 5120));
    conv_tile(src, ldsrc, sc0, dst, K, nd0, kt * 128, lds);
  }
}

__device__ __forceinline__ void rows_norm_mod(const float* xsrc, bf16_t* udst, int nrows, const LAS float* Av, const LAS float* Bv) {
  const int wid = threadIdx.x >> 6, lane = threadIdx.x & 63;
  for (int row = blockIdx.x * 8 + wid; row < nrows; row += gridDim.x * 8) {
    const float* xr = xsrc + (size_t)row * DM; f32x4 v[8]; float ss = 0.f;
#pragma unroll
    for (int i = 0; i < 8; ++i) { v[i] = __builtin_nontemporal_load((const f32x4*)(xr + (i * 64 + lane) * 4)); ss += v[i][0] * v[i][0] + v[i][1] * v[i][1] + v[i][2] * v[i][2] + v[i][3] * v[i][3]; }
    ss = wave_sum(ss); const float rs = rsqrtf(ss * (1.0f / DM) + EPS);
    bf16_t* ur = udst + (size_t)row * DM;
#pragma unroll
    for (int i = 0; i < 8; ++i) { const int c = (i * 64 + lane) * 4; const f32x4 a = *(const LAS f32x4*)(Av + c), b = *(const LAS f32x4*)(Bv + c); const f32x4 o = v[i] * rs * a + b;
      u32x2 w; w.x = cvt_pk_bf16(o[0], o[1]); w.y = cvt_pk_bf16(o[2], o[3]); *(u32x2*)(ur + c) = w; }
  }
}
template <bool HAS_U, bool YSPLIT = false>
__device__ __forceinline__ void rows_resid(const float* xsrc, const bf16_t* y, float* xdst, bf16_t* udst, int nrows, const LAS float* Gv, const LAS float* Av, const LAS float* Bv) {
  const int wid = threadIdx.x >> 6, lane = threadIdx.x & 63;
  for (int row = blockIdx.x * 8 + wid; row < nrows; row += gridDim.x * 8) {
    const bf16_t* yr = y + (size_t)row * DM; const float* xr = xsrc + (size_t)row * DM; f32x4 v[8]; float ss = 0.f;
#pragma unroll
    for (int i = 0; i < 8; ++i) {
      if (YSPLIT) { const float* yf = (const float*)y + (size_t)row * DM + (i * 64 + lane) * 4; v[i] = *(const f32x4*)yf + *(const f32x4*)(yf + (size_t)MC * DM) + *(const f32x4*)(yf + 2 * (size_t)MC * DM) + *(const f32x4*)(yf + 3 * (size_t)MC * DM); }
      else { const u32x2 yw = __builtin_nontemporal_load((const u32x2*)(y + ((size_t)((row >> 8) * 8 + i) << 16) + (row & 255) * 256 + lane * 4)); v[i] = (f32x4){bf_lo(yw.x), bf_hi(yw.x), bf_lo(yw.y), bf_hi(yw.y)}; } ss += v[i][0] * v[i][0] + v[i][1] * v[i][1] + v[i][2] * v[i][2] + v[i][3] * v[i][3]; }
    ss = wave_sum(ss); const float rs = rsqrtf(ss * (1.0f / DM) + EPS);
    float s2 = 0.f; float* xo = xdst + (size_t)row * DM;
#pragma unroll
    for (int i = 0; i < 8; ++i) { const int c = (i * 64 + lane) * 4; const f32x4 g = *(const LAS f32x4*)(Gv + c); const f32x4 xv = __builtin_nontemporal_load((const f32x4*)(xr + c));
      v[i] = xv + v[i] * rs * g; __builtin_nontemporal_store(v[i], (f32x4*)(xo + c)); s2 += v[i][0] * v[i][0] + v[i][1] * v[i][1] + v[i][2] * v[i][2] + v[i][3] * v[i][3]; }
    if (HAS_U) {
      s2 = wave_sum(s2); const float r2 = rsqrtf(s2 * (1.0f / DM) + EPS); bf16_t* ur = udst + (size_t)row * DM;
#pragma unroll
      for (int i = 0; i < 8; ++i) { const int c = (i * 64 + lane) * 4; const f32x4 a = *(const LAS f32x4*)(Av + c), b = *(const LAS f32x4*)(Bv + c); const f32x4 o = v[i] * r2 * a + b;
        u32x2 w; w.x = cvt_pk_bf16(o[0], o[1]); w.y = cvt_pk_bf16(o[2], o[3]); *(u32x2*)(ur + c) = w; }
    }
  }
}
template <bool FULL>
__device__ __forceinline__ void fill_vecs(const Params& p, int r, int mg, float gscale, int ng_post, int ng_pre, int msc, int msh, LAS float* Gv, LAS float* Av, LAS float* Bv) {
  const float* MODP = (const float*)(p.ws + OFF_MODP); const float* MODF = (const float*)(p.ws + OFF_MODF) + (size_t)r * NMODC;
  for (int c = threadIdx.x; c < DM; c += 512) {
    if (mg >= 0) Gv[c] = gscale * (FULL ? MODF[mg * DM + c] : modsum(MODP, r, mg * DM + c)) * p.norm_g[ng_post * DM + c];
    if (ng_pre >= 0) { Av[c] = p.norm_g[ng_pre * DM + c] * (1.0f + (FULL ? MODF[msc * DM + c] : modsum(MODP, r, msc * DM + c))); Bv[c] = FULL ? MODF[msh * DM + c] : modsum(MODP, r, msh * DM + c); }
  }
}

__device__ __forceinline__ void unpack8(const u32x4 w, float (&f)[8]) { f[0] = bf_lo(w.x); f[1] = bf_hi(w.x); f[2] = bf_lo(w.y); f[3] = bf_hi(w.y); f[4] = bf_lo(w.z); f[5] = bf_hi(w.z); f[6] = bf_lo(w.w); f[7] = bf_hi(w.w); }
__device__ __forceinline__ void phase_prep(const Params& p, LAS unsigned char* lds) {
  constexpr int BCS = 260;
  LAS float* Bc = (LAS float*)lds;
  LAS float* lol = (LAS float*)(lds + 66560);
  LAS float* Tt = (LAS float*)(lds + 70656);
  LAS float* Hs = (LAS float*)(lds + 71680);
  LAS unsigned char* Ql = lds + 73728;
  LAS unsigned char* Kd = lds + 73728 + 33792;
  const bf16_t* Q = (const bf16_t*)(p.ws + OFF_Q); const bf16_t* Kg = (const bf16_t*)(p.ws + OFF_K); const float* LO = (const float*)(p.ws + OFF_LO);
  bf16_t* QD = (bf16_t*)(p.ws + OFF_QD); bf16_t* KDT = (bf16_t*)(p.ws + OFF_KDT); bf16_t* PS = (bf16_t*)(p.ws + OFF_PS); float* AL = (float*)(p.ws + OFF_AL);
  const int tid = threadIdx.x, wid = tid >> 6, lane = tid & 63, fr = lane & 15, fq = lane >> 4;
  for (int wi = blockIdx.x; wi < 272 * 8; wi += gridDim.x) {
    const int item = wi >> 1, dir = wi & 1, gid = item >> 2, h = item & 3, row0 = gid * 64; const bool is_ctx = gid >= 256;
    const size_t itd = (size_t)wi;
    u32x4 rq[4], rk[4];
#pragma unroll
    for (int j = 0; j < 4; ++j) { const int v = tid + 512 * j, i = v >> 5, k8 = (v & 31) * 8;
      const size_t qoff = ((size_t)((gid >> 2) * 4 + h) << 16) + (size_t)((gid & 3) * 64 + i) * 256 + k8;
      rk[j] = *(const u32x4*)(Kg + qoff);
      rq[j] = is_ctx ? (u32x4){0, 0, 0, 0} : *(const u32x4*)(Q + qoff); }
    if (tid < 256) { const int i = tid >> 2, j4 = (tid & 3) * 4; *(LAS f32x4*)(lol + i * 16 + j4) = *(const f32x4*)(LO + (size_t)(row0 + i) * 32 + dir * 16 + j4); }
    __syncthreads();
    {
      const int half = tid >> 8, col = tid & 255, kk = h * 256 + col; float up[16];
#pragma unroll
      for (int r = 0; r < 16; ++r) up[r] = p.gate_up[(size_t)(dir * 16 + r) * 1024 + kk];
      const float bias = p.gate_bias[dir * 1024 + kk]; float la[32]; float tot = 0.f;
#pragma unroll
      for (int ii = 0; ii < 32; ++ii) { const int i = half * 32 + ii; float z = bias;
#pragma unroll
        for (int r4 = 0; r4 < 4; ++r4) { const f32x4 l = *(const LAS f32x4*)(lol + i * 16 + r4 * 4); z += l[0] * up[r4 * 4] + l[1] * up[r4 * 4 + 1] + l[2] * up[r4 * 4 + 2] + l[3] * up[r4 * 4 + 3]; }
        la[ii] = (fminf(z, 0.f) - __logf(1.0f + __expf(-fabsf(z)))) * (1.0f / 16.0f); tot += la[ii]; }
      Hs[half * 256 + col] = tot;
      __syncthreads();
      float run = half ? Hs[col] : 0.f;
#pragma unroll
      for (int ii = 0; ii < 32; ++ii) { const int i = half * 32 + ii; if (dir == 0) { run += la[ii]; Bc[i * BCS + col] = run; } else { Bc[i * BCS + col] = run; run += la[ii]; } }
      if (half) { Tt[col] = run; AL[itd * 256 + col] = __expf(run); }
    }
    __syncthreads();
#pragma unroll
    for (int j = 0; j < 4; ++j) { const int v = tid + 512 * j, i = v >> 5, k8 = (v & 31) * 8; float q[8], kv[8]; unpack8(rq[j], q); unpack8(rk[j], kv);
      const f32x4 x0 = *(const LAS f32x4*)(Bc + i * BCS + k8), x1 = *(const LAS f32x4*)(Bc + i * BCS + k8 + 4), t0 = *(const LAS f32x4*)(Tt + k8), t1 = *(const LAS f32x4*)(Tt + k8 + 4);
      float oq[8], ok[8], op[8];
#pragma unroll
      for (int e = 0; e < 8; ++e) { const float x = e < 4 ? x0[e & 3] : x1[e & 3], T = e < 4 ? t0[e & 3] : t1[e & 3];
        const float eq = __expf(dir == 0 ? x : T - x), ek = __expf(dir == 0 ? T - x : x); const float qs = q[e] * 0.0625f;
        oq[e] = qs * eq; ok[e] = kv[e] * ek; op[e] = qs * __builtin_amdgcn_rcpf(ek); }
      u32x4 w;
      if (!is_ctx) { w.x = cvt_pk_bf16(oq[0], oq[1]); w.y = cvt_pk_bf16(oq[2], oq[3]); w.z = cvt_pk_bf16(oq[4], oq[5]); w.w = cvt_pk_bf16(oq[6], oq[7]);
        *(u32x4*)(QD + itd * 16384 + i * 256 + k8) = w;
        w.x = cvt_pk_bf16(op[0], op[1]); w.y = cvt_pk_bf16(op[2], op[3]); w.z = cvt_pk_bf16(op[4], op[5]); w.w = cvt_pk_bf16(op[6], op[7]);
        *(LAS u32x4*)(Ql + i * 528 + k8 * 2) = w; }
      w.x = cvt_pk_bf16(ok[0], ok[1]); w.y = cvt_pk_bf16(ok[2], ok[3]); w.z = cvt_pk_bf16(ok[4], ok[5]); w.w = cvt_pk_bf16(ok[6], ok[7]);
      *(LAS u32x4*)(Kd + i * 528 + k8 * 2) = w; }
    __syncthreads();
#pragma unroll
    for (int j = 0; j < 4; ++j) { const int v = tid + 512 * j, k = v >> 3, s8 = (v & 7) * 8; unsigned short o[8];
#pragma unroll
      for (int e = 0; e < 8; ++e) o[e] = *(const LAS unsigned short*)(Kd + (s8 + e) * 528 + k * 2);
      u32x4 w; w.x = (unsigned)o[0] | ((unsigned)o[1] << 16); w.y = (unsigned)o[2] | ((unsigned)o[3] << 16); w.z = (unsigned)o[4] | ((unsigned)o[5] << 16); w.w = (unsigned)o[6] | ((unsigned)o[7] << 16);
      *(u32x4*)(KDT + itd * 16384 + k * 64 + s8) = w; }
    if (!is_ctx) {
      const int cb = wid >> 1, sb0 = (wid & 1) * 2; f32x4 acc[2] = {{0, 0, 0, 0}, {0, 0, 0, 0}};
#pragma unroll
      for (int ks = 0; ks < 8; ++ks) { const bf16x8 qf = *(const LAS bf16x8*)(Ql + (cb * 16 + fr) * 528 + (ks * 32 + fq * 8) * 2);
#pragma unroll
        for (int t = 0; t < 2; ++t) { const bf16x8 kf = *(const LAS bf16x8*)(Kd + ((sb0 + t) * 16 + fr) * 528 + (ks * 32 + fq * 8) * 2); acc[t] = __builtin_amdgcn_mfma_f32_16x16x32_bf16(kf, qf, acc[t], 0, 0, 0); } }
      const int c = cb * 16 + fr;
#pragma unroll
      for (int t = 0; t < 2; ++t) { const int s0 = (sb0 + t) * 16 + fq * 4; float o[4];
#pragma unroll
        for (int r = 0; r < 4; ++r) { const int s = s0 + r; const bool keep = dir == 0 ? (s <= c) : (s >= c); o[r] = keep ? acc[t][r] : 0.f; }
        u32x2 w; w.x = cvt_pk_bf16(o[0], o[1]); w.y = cvt_pk_bf16(o[2], o[3]); *(u32x2*)(PS + itd * 4096 + c * 64 + s0) = w; }
    }
    __syncthreads();
  }
}

__device__ __forceinline__ void phase_chain(const Params& p, LAS unsigned char* lds, int vb) {
  constexpr int KDT_O = 0, VT_O = 36864, PS_O = VT_O + 9216, QD_O = PS_O + 9216, SB_O = QD_O + 33792, AL_O = SB_O + 33792;
  const bf16_t* QD = (const bf16_t*)(p.ws + OFF_QD); const bf16_t* KDT = (const bf16_t*)(p.ws + OFF_KDT); const bf16_t* PS = (const bf16_t*)(p.ws + OFF_PS);
  const bf16_t* VT = (const bf16_t*)(p.ws + OFF_VT); const float* AL = (const float*)(p.ws + OFF_AL);
  const int tid = threadIdx.x, wid = __builtin_amdgcn_readfirstlane(tid >> 6), lane = tid & 63, fr = lane & 15, fq = lane >> 4;
  for (int cid = vb; cid < 256; cid += gridDim.x) {
    const int xcd = cid & 7, w = cid >> 3, vs = w & 7, bhd = xcd * 4 + (w >> 3), b = bhd >> 3, h = (bhd >> 1) & 3, dir = bhd & 1;
    bf16_t* O = (bf16_t*)(p.ws + (dir ? OFF_OB : OFF_OF));
    f32x4 S[2][4];
#pragma unroll
    for (int a = 0; a < 2; ++a)
#pragma unroll
      for (int v = 0; v < 4; ++v) S[a][v] = (f32x4){0.f, 0.f, 0.f, 0.f};
    u32x4 rk[4], rq[4], rv, rp; float ra = 0.f;
#pragma unroll
    for (int j = 0; j < 4; ++j) rq[j] = (u32x4){0, 0, 0, 0};
    rp = (u32x4){0, 0, 0, 0};
#define CH_GID(st) ((st) < 4 ? 256 + b * 4 + (dir ? 3 - (st) : (st)) : b * 64 + (dir ? 67 - (st) : (st) - 4))
#define CH_LOAD(st) do { const int gid_ = CH_GID(st); const size_t it_ = ((size_t)gid_ * 4 + h) * 2 + dir; \
      _Pragma("unroll") for (int j = 0; j < 4; ++j) rk[j] = *(const u32x4*)(KDT + it_ * 16384 + (size_t)(tid + 512 * j) * 8); \
      rv = *(const u32x4*)(VT + ((size_t)gid_ * 2048 + h * 512 + vs * 64) * 64 + (size_t)tid * 8); \
      if ((st) >= 4) { _Pragma("unroll") for (int j = 0; j < 4; ++j) rq[j] = *(const u32x4*)(QD + it_ * 16384 + (size_t)(tid + 512 * j) * 8); rp = *(const u32x4*)(PS + it_ * 4096 + (size_t)tid * 8); } \
      if (tid < 256) ra = AL[it_ * 256 + tid]; } while (0)
    CH_LOAD(0);
    for (int st = 0; st < 68; ++st) {
      const bool latent = st >= 4;
#pragma unroll
      for (int j = 0; j < 4; ++j) { const int v = tid + 512 * j; *(LAS u32x4*)(lds + KDT_O + (v >> 3) * 144 + (v & 7) * 16) = rk[j]; }
      *(LAS u32x4*)(lds + VT_O + (tid >> 3) * 144 + (tid & 7) * 16) = rv;
      if (latent) {
#pragma unroll
        for (int j = 0; j < 4; ++j) { const int v = tid + 512 * j; *(LAS u32x4*)(lds + QD_O + (v >> 5) * 528 + (v & 31) * 16) = rq[j]; }
        *(LAS u32x4*)(lds + PS_O + (tid >> 3) * 144 + (tid & 7) * 16) = rp;
#pragma unroll
        for (int a = 0; a < 2; ++a)
#pragma unroll
          for (int vb = 0; vb < 4; ++vb) { u32x2 wv; wv.x = cvt_pk_bf16(S[a][vb][0], S[a][vb][1]); wv.y = cvt_pk_bf16(S[a][vb][2], S[a][vb][3]);
            *(LAS u32x2*)(lds + SB_O + (vb * 16 + fr) * 528 + ((2 * wid + a) * 16 + fq * 4) * 2) = wv; }
      }
      if (tid < 256) *(LAS float*)(lds + AL_O + tid * 4) = ra;
      __syncthreads();
      const int gid = CH_GID(st);
      if (st + 1 < 68) CH_LOAD(st + 1);
      if (latent) {
        const int cb = wid >> 1, vb0 = (wid & 1) * 2; f32x4 o[2] = {{0, 0, 0, 0}, {0, 0, 0, 0}};
#pragma unroll
        for (int ks = 0; ks < 2; ++ks) { const bf16x8 pf = *(const LAS bf16x8*)(lds + PS_O + (cb * 16 + fr) * 144 + (ks * 32 + fq * 8) * 2);
#pragma unroll
          for (int t = 0; t < 2; ++t) { const bf16x8 vf = *(const LAS bf16x8*)(lds + VT_O + ((vb0 + t) * 16 + fr) * 144 + (ks * 32 + fq * 8) * 2); o[t] = __builtin_amdgcn_mfma_f32_16x16x32_bf16(vf, pf, o[t], 0, 0, 0); } }
#pragma unroll
        for (int ks = 0; ks < 8; ++ks) { const bf16x8 qf = *(const LAS bf16x8*)(lds + QD_O + (cb * 16 + fr) * 528 + (ks * 32 + fq * 8) * 2);
#pragma unroll
          for (int t = 0; t < 2; ++t) { const bf16x8 sf = *(const LAS bf16x8*)(lds + SB_O + ((vb0 + t) * 16 + fr) * 528 + (ks * 32 + fq * 8) * 2); o[t] = __builtin_amdgcn_mfma_f32_16x16x32_bf16(sf, qf, o[t], 0, 0, 0); } }
        const size_t row = (size_t)gid * 64 + cb * 16 + fr;
#pragma unroll
        for (int t = 0; t < 2; ++t) { u32x2 wv; wv.x = cvt_pk_bf16(o[t][0], o[t][1]); wv.y = cvt_pk_bf16(o[t][2], o[t][3]); __builtin_nontemporal_store(wv, (u32x2*)(O + row * 2048 + h * 512 + vs * 64 + (vb0 + t) * 16 + fq * 4)); }
      }
#pragma unroll
      for (int a = 0; a < 2; ++a) {
        const f32x4 al = *(const LAS f32x4*)(lds + AL_O + ((2 * wid + a) * 16 + fq * 4) * 4);
        bf16x8 kf[2];
#pragma unroll
        for (int ks = 0; ks < 2; ++ks) kf[ks] = *(const LAS bf16x8*)(lds + KDT_O + ((2 * wid + a) * 16 + fr) * 144 + (ks * 32 + fq * 8) * 2);
#pragma unroll
        for (int vb = 0; vb < 4; ++vb) { S[a][vb] *= al;
#pragma unroll
          for (int ks = 0; ks < 2; ++ks) { const bf16x8 vf = *(const LAS bf16x8*)(lds + VT_O + (vb * 16 + fr) * 144 + (ks * 32 + fq * 8) * 2); S[a][vb] = __builtin_amdgcn_mfma_f32_16x16x32_bf16(kf[ks], vf, S[a][vb], 0, 0, 0); } }
      }
      __syncthreads();
    }
#undef CH_LOAD
#undef CH_GID
  }
}

__device__ __forceinline__ void phase_mix_elem(const Params& p) {
  const bf16_t* PBc = (const bf16_t*)(p.ws + OFF_PBC); const bf16_t* PBr = (const bf16_t*)(p.ws + OFF_PBR);
  const bf16_t* OF = (const bf16_t*)(p.ws + OFF_OF); const bf16_t* OB = (const bf16_t*)(p.ws + OFF_OB);
  bf16_t* AC = (bf16_t*)(p.ws + OFF_ACONV); bf16_t* AG = (bf16_t*)(p.ws + OFF_AGLA);
  const int wid = threadIdx.x >> 6, lane = threadIdx.x & 63;
  for (int row = blockIdx.x * 8 + wid; row < ML; row += gridDim.x * 8) {
    const int gc = row & 63; const bool hasl = gc != 0, hasr = gc != 63;
#pragma unroll
    for (int half = 0; half < 2; ++half) {
      const int c = half * 512 + lane * 8; float zc[8], zl[8], zr[8], t0[8], t1[8], bg[8];
      const bf16_t* pr = PBc + ((size_t)((row >> 8) * 12 + (c >> 8)) << 16) + (row & 255) * 256 + (c & 255);
      constexpr int TC = 4 << 16, TH = 8 << 16;
      unpack8(*(const u32x4*)(pr + TC), t0); unpack8(*(const u32x4*)(pr + TH), t1);
#pragma unroll
      for (int e = 0; e < 8; ++e) zc[e] = t0[e] * t1[e];
      if (hasl) { unpack8(*(const u32x4*)(pr - 256 + TC), t0); unpack8(*(const u32x4*)(pr - 256 + TH), t1);
#pragma unroll
        for (int e = 0; e < 8; ++e) zl[e] = t0[e] * t1[e]; } else {
#pragma unroll
        for (int e = 0; e < 8; ++e) zl[e] = 0.f; }
      if (hasr) { unpack8(*(const u32x4*)(pr + 256 + TC), t0); unpack8(*(const u32x4*)(pr + 256 + TH), t1);
#pragma unroll
        for (int e = 0; e < 8; ++e) zr[e] = t0[e] * t1[e]; } else {
#pragma unroll
        for (int e = 0; e < 8; ++e) zr[e] = 0.f; }
      unpack8(*(const u32x4*)pr, bg);
      float o[8];
#pragma unroll
      for (int e = 0; e < 8; ++e) o[e] = bg[e] * (p.conv_w[c + e] * zl[e] + p.conv_w[1024 + c + e] * zc[e] + p.conv_w[2048 + c + e] * zr[e] + p.conv_b[c + e]);
      u32x4 w; w.x = cvt_pk_bf16(o[0], o[1]); w.y = cvt_pk_bf16(o[2], o[3]); w.z = cvt_pk_bf16(o[4], o[5]); w.w = cvt_pk_bf16(o[6], o[7]);
      *(u32x4*)(AC + (size_t)row * 1024 + c) = w;
    }
#pragma unroll
    for (int h = 0; h < 4; ++h) {
      const int c = h * 512 + lane * 8; float a[8], b[8], r[8], o[8]; float ss = 0.f;
      unpack8(__builtin_nontemporal_load((const u32x4*)(OF + (size_t)row * 2048 + c)), a); unpack8(__builtin_nontemporal_load((const u32x4*)(OB + (size_t)row * 2048 + c)), b); unpack8(*(const u32x4*)(PBr + ((size_t)((row >> 8) * 8 + (c >> 8)) << 16) + (row & 255) * 256 + (c & 255)), r);
#pragma unroll
      for (int e = 0; e < 8; ++e) { a[e] += b[e]; ss += a[e] * a[e]; }
      ss = wave_sum(ss); const float rs = rsqrtf(ss * (1.0f / HV) + EPS);
#pragma unroll
      for (int e = 0; e < 8; ++e) o[e] = a[e] * rs * p.gla_norm_g[c + e] * fsilu(r[e]);
      u32x4 w; w.x = cvt_pk_bf16(o[0], o[1]); w.y = cvt_pk_bf16(o[2], o[3]); w.z = cvt_pk_bf16(o[4], o[5]); w.w = cvt_pk_bf16(o[6], o[7]);
      *(u32x4*)(AG + (size_t)row * 2048 + c) = w;
    }
  }
}


#define XB_TMO      128
#define XB_XCNT(j)  (256  + 64 * (j))
#define XB_XSUB(j)  (1280 + 64 * (j))
#define XB_XGEN(j)  (2304 + 64 * (j))
#define XB_TOP      3328
#define XB_TOPGEN   3392
#define XCD_BAR_WORDS 3456
#define XB_SPIN_CAP (1u << 18)
__device__ __forceinline__ unsigned xb_ld(unsigned* p)              { return __hip_atomic_load(p, __ATOMIC_RELAXED, __HIP_MEMORY_SCOPE_AGENT); }
__device__ __forceinline__ unsigned xb_add(unsigned* p, unsigned v) { return __hip_atomic_fetch_add(p, v, __ATOMIC_RELAXED, __HIP_MEMORY_SCOPE_AGENT); }
__device__ __forceinline__ unsigned xb_xcc_id() { return (unsigned)__builtin_amdgcn_s_getreg((3 << 11) | 20) & 0xFu; }
#define XB_SPIN(cond, bar) do { unsigned _sp = 0; while (cond) { __builtin_amdgcn_s_sleep(1); \
    if ((++_sp & 255u) == 0u) { if (xb_ld(&(bar)[XB_TMO])) break; if (_sp > XB_SPIN_CAP) { atomicAdd(&(bar)[XB_TMO], 1u); break; } } } } while (0)
struct XcdBarrier { unsigned* bar; unsigned x; volatile LAS unsigned* st; };
__device__ __forceinline__ XcdBarrier xcd_barrier_post(unsigned* bar, volatile LAS unsigned* st) {
    XcdBarrier b; b.bar = bar; b.x = xb_xcc_id(); b.st = st;
    if (threadIdx.x == 0) st[2] = xb_add(&bar[XB_XCNT(b.x)], 1u);
    return b;
}
__device__ __forceinline__ void xcd_barrier_complete(unsigned* bar, unsigned x, unsigned& nloc, unsigned& nx) {
    const unsigned G = gridDim.x * gridDim.y * gridDim.z;
    unsigned sum, cnt, mine, sp = 0u;
    for (;;) {
        sum = 0u; cnt = 0u; mine = 0u;
#pragma unroll
        for (unsigned j = 0; j < 16; ++j) { const unsigned c = xb_ld(&bar[XB_XCNT(j)]); sum += c; cnt += (c > 0u) ? 1u : 0u; mine = (j == x) ? c : mine; }
        if (sum == G) break;
        __builtin_amdgcn_s_sleep(1);
        if ((++sp & 255u) == 0u) { if (xb_ld(&bar[XB_TMO])) break; if (sp > XB_SPIN_CAP) { atomicAdd(&bar[XB_TMO], 1u); break; } }
    }
    nloc = mine > 0u ? mine : 1u; nx = cnt > 0u ? cnt : 1u;
}
__device__ __forceinline__ void xcd_barrier(const XcdBarrier& b) {
    asm volatile("s_waitcnt vmcnt(0)" ::: "memory");
    __syncthreads();
    if (threadIdx.x == 0) {
        unsigned* bar = b.bar;
        __builtin_amdgcn_s_waitcnt(0);
        unsigned nloc = b.st[0], nx = b.st[1];
        if (nloc == 0u) { xcd_barrier_complete(bar, b.x, nloc, nx); b.st[0] = nloc; b.st[1] = nx; }
        const unsigned old = xb_add(&bar[XB_XSUB(b.x)], 1u);
        const unsigned gen = old / nloc;
        if (old + 1u == (gen + 1u) * nloc) {
            __builtin_amdgcn_fence(__ATOMIC_RELEASE, "agent");
            asm volatile("s_waitcnt vmcnt(0)" ::: "memory");
            const unsigned og = xb_add(&bar[XB_TOP], 1u);
            const unsigned tg = og / nx;
            if (og + 1u == (tg + 1u) * nx) xb_add(&bar[XB_TOPGEN], 1u);
            else XB_SPIN(xb_ld(&bar[XB_TOPGEN]) == tg, bar);
            __builtin_amdgcn_fence(__ATOMIC_ACQUIRE, "agent");
            xb_add(&bar[XB_XGEN(b.x)], 1u);
            asm volatile("s_waitcnt vmcnt(0)" ::: "memory");
        } else {
            XB_SPIN(xb_ld(&bar[XB_XGEN(b.x)]) == gen, bar);
            __builtin_amdgcn_fence(__ATOMIC_ACQUIRE, "agent");
            asm volatile("s_waitcnt vmcnt(0)" ::: "memory");
        }
    }
    __syncthreads();
}

__global__ void __launch_bounds__(512, 2) mk_fwd(Params p) {
  extern __shared__ __attribute__((aligned(16))) unsigned char lds_raw[];
  LAS unsigned char* lds = (LAS unsigned char*)lds_raw;
  cg::grid_group grid = cg::this_grid();
  unsigned char* ws = p.ws;
  const int lo = p.ph_lo, hi = p.ph_hi;
#define IN(k) (lo <= (k) && (k) < hi)
#define SEAM(k) do { if (IN(k) && IN((k) + 1)) xcd_barrier(xbar); } while (0)
  volatile LAS unsigned* xst = (volatile LAS unsigned*)(lds + LDS_BYTES - 16);
  if (threadIdx.x == 0) { xst[0] = 0u; xst[1] = 0u; }
  __syncthreads();
  XcdBarrier xbar; xbar.bar = (unsigned*)(p.ws + OFF_BAR); xbar.x = 0; xbar.st = xst;
  if (hi - lo > 1) xbar = xcd_barrier_post((unsigned*)(p.ws + OFF_BAR), xst);
  if (hi < 0) grid.sync();
  LAS float* Gv = (LAS float*)lds; LAS float* Av = (LAS float*)(lds + 8192); LAS float* Bv = (LAS float*)(lds + 16384);
  bf16_t* U = (bf16_t*)(ws + OFF_U);

  if (IN(0)) {
    phase_mod(p, lds);
    int tb = 0;
    conv_job(p.ffn1_w_in, 2 * DFF, (bf16_t*)(ws + OFF_W1IN), DM, 176, 1, tb, lds);
    conv_job(p.w_in, DIN, (bf16_t*)(ws + OFF_WPA), DM, 65, 2, tb, lds);
    conv_job(p.ffn1_w_out, DM, (bf16_t*)(ws + OFF_W1OUT), DFF, 32, 0, tb, lds);
  }
  SEAM(0);
  int vb = (int)blockIdx.x;
  if (IN(0) && IN(1)) {
    if (threadIdx.x == 0) {
      unsigned* bar = (unsigned*)(p.ws + OFF_BAR); bool ok = (gridDim.x & 7u) == 0u; const unsigned per = gridDim.x >> 3;
      for (unsigned j = 0; j < 16; ++j) { const unsigned c = xb_ld(&bar[XB_XCNT(j)]); if (j < 8 ? c != per : c != 0u) ok = false; }
      xst[3] = ok ? xst[2] * 8u + xbar.x : blockIdx.x;
    }
    __syncthreads();
    vb = (int)xst[3];
  }
  if (IN(1)) {
    { const float* MODP = (const float*)(ws + OFF_MODP); float* MODF = (float*)(ws + OFF_MODF);
      for (int i = blockIdx.x * 512 + threadIdx.x; i < 5 * NMODC; i += gridDim.x * 512) MODF[i] = modsum(MODP, i / NMODC, i % NMODC); }
    for (int r = 0; r < 5; ++r) {
      fill_vecs<false>(p, r, -1, 0.f, 0, 0, 1, 0, Gv, Av, Bv); __syncthreads();
      if (r < 4) rows_norm_mod(p.x + (size_t)r * SEQ * DM, U + (size_t)r * SEQ * DM, SEQ, Av, Bv);
      else rows_norm_mod(p.ctx, U + (size_t)ML * DM, MC, Av, Bv);
      __syncthreads();
    }
  }
  SEAM(1);
  if (IN(2)) { EpiSwiglu E{(bf16_t*)(ws + OFF_ACT)}; run_gemm_v(vb, lds, U, (const bf16_t*)(ws + OFF_W1IN), MT, 2 * DFF, DM, E); __syncthreads(); conv_queue(p, 0, lds); }
  SEAM(2);
  if (IN(3)) {
    { EpiBf16 E{(bf16_t*)(ws + OFF_Y), 8}; run_gemm_v(vb, lds, (const bf16_t*)(ws + OFF_ACT), (const bf16_t*)(ws + OFF_W1OUT), ML, DM, DFF, E); }
    { EpiF32Split E{(float*)(ws + OFF_YC), DM, (size_t)MC * DM}; run_gemm_v(vb, lds, (const bf16_t*)(ws + OFF_ACT) + (size_t)ML * DFF, (const bf16_t*)(ws + OFF_W1OUT), MC, DM, DFF, E, 4); }
    __syncthreads(); conv_queue(p, 0, lds);
  }
  SEAM(3);
  if (IN(4)) {
    conv_queue(p, 0, lds);
    const bf16_t* Y = (const bf16_t*)(ws + OFF_Y);
    for (int r = 0; r < 5; ++r) {
      fill_vecs<true>(p, r, 2, 0.5f, 1, 2, 4, 3, Gv, Av, Bv); __syncthreads();
      if (r < 4) rows_resid<true>(p.x + (size_t)r * SEQ * DM, Y + (size_t)r * SEQ * DM, p.out + (size_t)r * SEQ * DM, U + (size_t)r * SEQ * DM, SEQ, Gv, Av, Bv);
      else rows_resid<true, true>(p.ctx, (const bf16_t*)(ws + OFF_YC), (float*)(ws + OFF_CX1), U + (size_t)ML * DM, MC, Gv, Av, Bv);
      __syncthreads();
    }
  }
  SEAM(4);
  if (IN(5)) { EpiPA E{(bf16_t*)(ws + OFF_Q), (bf16_t*)(ws + OFF_K), (bf16_t*)(ws + OFF_VT), (float*)(ws + OFF_LO)}; run_gemm_v(vb, lds, U, (const bf16_t*)(ws + OFF_WPA), MT, 4352, DM, E); __syncthreads(); conv_queue(p, 1, lds); }
  SEAM(5);
  if (IN(6)) phase_prep(p, lds);
  SEAM(6);
  if (IN(7)) phase_chain(p, lds, vb);
  SEAM(7);
  if (IN(8)) { EpiPB E{(bf16_t*)(ws + OFF_PBC), (bf16_t*)(ws + OFF_PBR), (bf16_t*)(ws + OFF_PBG)}; run_gemm_v(vb, lds, U, (const bf16_t*)(ws + OFF_WPB), ML, 9216, DM, E); }
  SEAM(8);
  if (IN(9)) { conv_queue(p, 1, lds); phase_mix_elem(p); }
  SEAM(9);
  if (IN(10)) { EpiGateT E{(const bf16_t*)(ws + OFF_PBG), (bf16_t*)(ws + OFF_T)}; run_gemm_v(vb, lds, (const bf16_t*)(ws + OFF_ACONV), (const bf16_t*)(ws + OFF_WCO), ML, DM, CONVW, E); }
  if (IN(10) && IN(11)) { asm volatile("s_waitcnt vmcnt(0)" ::: "memory"); __syncthreads(); }
  if (IN(11)) { EpiGateZ E{(const bf16_t*)(ws + OFF_PBG), (const bf16_t*)(ws + OFF_T), (bf16_t*)(ws + OFF_Z)}; run_gemm_v(vb, lds, (const bf16_t*)(ws + OFF_AGLA), (const bf16_t*)(ws + OFF_WGO), ML, DM, DM, E); }
  SEAM(11);
  if (IN(12)) { EpiBf16 E{(bf16_t*)(ws + OFF_Y2), 8}; run_gemm_v(vb, lds, (const bf16_t*)(ws + OFF_Z), (const bf16_t*)(ws + OFF_WO), ML, DM, DM, E); }
  SEAM(12);
  if (IN(13)) {
    const bf16_t* Y = (const bf16_t*)(ws + OFF_Y2);
    for (int r = 0; r < 4; ++r) {
      fill_vecs<true>(p, r, 5, 1.0f, 3, 4, 7, 6, Gv, Av, Bv); __syncthreads();
      rows_resid<true>(p.out + (size_t)r * SEQ * DM, Y + (size_t)r * SEQ * DM, p.out + (size_t)r * SEQ * DM, U + (size_t)r * SEQ * DM, SEQ, Gv, Av, Bv);
      __syncthreads();
    }
  }
  SEAM(13);
  if (IN(14)) { EpiSwiglu E{(bf16_t*)(ws + OFF_ACT)}; run_gemm_v(vb, lds, U, (const bf16_t*)(ws + OFF_W1IN), ML, 2 * DFF, DM, E); }
  SEAM(14);
  if (IN(15)) { EpiBf16 E{(bf16_t*)(ws + OFF_Y), 8}; run_gemm_v(vb, lds, (const bf16_t*)(ws + OFF_ACT), (const bf16_t*)(ws + OFF_W1OUT), ML, DM, DFF, E); }
  SEAM(15);
  if (IN(16)) {
    const bf16_t* Y = (const bf16_t*)(ws + OFF_Y);
    for (int r = 0; r < 4; ++r) {
      fill_vecs<true>(p, r, 8, 0.5f, 5, -1, 0, 0, Gv, Av, Bv); __syncthreads();
      rows_resid<false>(p.out + (size_t)r * SEQ * DM, Y + (size_t)r * SEQ * DM, p.out + (size_t)r * SEQ * DM, nullptr, SEQ, Gv, Av, Bv);
      __syncthreads();
    }
  }
}
constexpr int NPHASE = 17;

extern "C" void kernel_launch(void* const* d_in, const int* in_sizes, int n_in, void* d_out, int out_size, void* d_ws, size_t ws_size, hipStream_t stream) {
  static int grid_blocks = 0;
  if (!grid_blocks) {
    int dev = 0, cus = 0, per_cu = 0;
    (void)hipGetDevice(&dev);
    (void)hipDeviceGetAttribute(&cus, hipDeviceAttributeMultiprocessorCount, dev);
    (void)hipFuncSetAttribute((const void*)mk_fwd, hipFuncAttributeMaxDynamicSharedMemorySize, LDS_BYTES);
    (void)hipOccupancyMaxActiveBlocksPerMultiprocessor(&per_cu, mk_fwd, 512, LDS_BYTES);
    if (per_cu < 1) { fprintf(stderr, "kernel_launch: occupancy query returned %d\n", per_cu); per_cu = 1; }
    grid_blocks = cus;
  }
  if (ws_size < WS_NEED) { fprintf(stderr, "kernel_launch: workspace too small (%zu < %zu)\n", ws_size, (size_t)WS_NEED); return; }
  Params p{};
  const float** pp = (const float**)&p;
  for (int i = 0; i < 20; ++i) pp[i] = (const float*)d_in[i];
  p.out = (float*)d_out; p.ws = (unsigned char*)d_ws;
#if MULTI_LAUNCH
  for (int ph = 0; ph < NPHASE; ++ph) { p.ph_lo = ph; p.ph_hi = ph + 1; hipLaunchKernelGGL(mk_fwd, dim3(grid_blocks), dim3(512), LDS_BYTES, stream, p); }
#else
  p.ph_lo = 0; p.ph_hi = NPHASE;
  (void)hipMemsetAsync((unsigned char*)d_ws + OFF_BAR, 0, (XCD_BAR_WORDS + 256) * 4, stream);
  void* args[] = {&p};
  hipError_t e = hipLaunchCooperativeKernel((void*)mk_fwd, dim3(grid_blocks), dim3(512), args, LDS_BYTES, stream);
  if (e != hipSuccess) fprintf(stderr, "cooperative launch failed: %s (grid %d)\n", hipGetErrorString(e), grid_blocks);
#endif
}
```
